# Optimizing an MI355X kernel written in HIP

```python
import math
import jax, jax.numpy as jnp
from jax import lax
import numpy as np

D_MODEL = 1024
BATCH = 4
SEQ = 4096
DEPTH = 1

CHUNK = 64
Q_BLOCK = 128
HEAD_DIM = 64
N_RET_HEADS = 8
N_FOX_HEADS = 8
RET_WIDTH = N_RET_HEADS * HEAD_DIM
FOX_WIDTH = N_FOX_HEADS * HEAD_DIM
MIX_WIDTH = RET_WIDTH + FOX_WIDTH
N_MEM = 256
N_XATTN_HEADS = 4
XATTN_HEAD_DIM = D_MODEL // N_XATTN_HEADS
D_FF = -(-8 * D_MODEL // (3 * 256)) * 256
ROPE_BASE = 10000.0
EPS = 1e-6
NEG_INF = -1e30
IN_SIZES = (RET_WIDTH, RET_WIDTH, RET_WIDTH, RET_WIDTH, FOX_WIDTH, FOX_WIDTH, FOX_WIDTH, N_FOX_HEADS)
IN_WIDTH = sum(IN_SIZES)

kernel_name = "hymba_retention_fox_hybrid_block"


def _split_points(sizes):
    pts, acc = [], 0
    for s in sizes[:-1]:
        acc += s
        pts.append(acc)
    return pts


def rmsnorm(x, g):
    xf = x.astype(jnp.float32)
    y = xf * lax.rsqrt(jnp.mean(xf * xf, axis=-1, keepdims=True) + EPS)
    return (y * g.astype(jnp.float32)).astype(x.dtype)


def head_group_norm(x, g):
    xf = x.astype(jnp.float32)
    mu = jnp.mean(xf, axis=-1, keepdims=True)
    xc = xf - mu
    var = jnp.mean(xc * xc, axis=-1, keepdims=True)
    return (xc * lax.rsqrt(var + EPS) * g.astype(jnp.float32)).astype(x.dtype)


def rotary(x, pos):
    d = x.shape[-1]
    inv_freq = ROPE_BASE ** (-jnp.arange(0, d, 2, dtype=jnp.float32) / d)
    ang = pos[:, None] * inv_freq[None, :]
    cos = jnp.cos(ang)[:, None, :].astype(x.dtype)
    sin = jnp.sin(ang)[:, None, :].astype(x.dtype)
    x1, x2 = x[..., : d // 2], x[..., d // 2:]
    return jnp.concatenate([x1 * cos - x2 * sin, x1 * sin + x2 * cos], axis=-1)


def chunk_retention(q, k, v):
    B, T, H, d = q.shape
    dv = v.shape[-1]
    nc = T // CHUNK
    dt = q.dtype
    log_g = jnp.log(1.0 - 2.0 ** (-5.0 - jnp.arange(H, dtype=jnp.float32)))
    idx = jnp.arange(CHUNK, dtype=jnp.float32)
    intra_decay = jnp.exp(log_g[:, None, None] * jnp.abs(idx[:, None] - idx[None, :])).astype(dt)
    q_decay = jnp.exp(log_g[None, :] * (idx[:, None] + 1.0)).astype(dt)
    k_decay = jnp.exp(log_g[None, :] * (CHUNK - 1.0 - idx[:, None])).astype(dt)
    chunk_decay = jnp.exp(log_g * CHUNK).astype(dt)[:, None, None]

    qc = (q * (d ** -0.5)).reshape(B, nc, CHUNK, H, d)
    kc = k.reshape(B, nc, CHUNK, H, d)
    vc = v.reshape(B, nc, CHUNK, H, dv)

    scores = jnp.einsum('bnihd,bnjhd->bnhij', qc, kc) * intra_decay
    intra = jnp.einsum('bnhij,bnjhe->bnihe', scores, vc)

    kv = jnp.einsum('bnjhd,bnjhe->nbhde', kc * k_decay[:, :, None], vc)

    def step(state, kv_c):
        return state * chunk_decay + kv_c, state

    _, s_prev = lax.scan(step, jnp.zeros((B, H, d, dv), kv.dtype), kv)
    inter = jnp.einsum('bnihd,nbhde->bnihe', qc * q_decay[:, :, None], s_prev)
    return (intra + inter).reshape(B, T, H, dv)


def forgetting_attention(q, k, v, log_f):
    B, T, H, d = q.shape
    F = jnp.cumsum(log_f, axis=1).transpose(0, 2, 1)
    qh = (q * (d ** -0.5)).transpose(0, 2, 1, 3)
    kh = k.transpose(0, 2, 1, 3)
    vh = v.transpose(0, 2, 1, 3)
    qpos = jnp.arange(Q_BLOCK)
    outs = []
    for blk in range(T // Q_BLOCK):
        q0 = blk * Q_BLOCK
        kend = q0 + Q_BLOCK
        logits = jnp.einsum('bhqd,bhkd->bhqk', qh[:, :, q0:kend], kh[:, :, :kend]).astype(jnp.float32)
        logits = logits + F[:, :, q0:kend, None] - F[:, :, None, :kend]
        causal = (q0 + qpos)[:, None] >= jnp.arange(kend)[None, :]
        logits = jnp.where(causal, logits, NEG_INF)
        p = jax.nn.softmax(logits, axis=-1).astype(v.dtype)
        outs.append(jnp.einsum('bhqk,bhkd->bhqd', p, vh[:, :, :kend]))
    return jnp.concatenate(outs, axis=2).transpose(0, 2, 1, 3)


def memory_cross_attention(hn, mem, w_xq, w_xkv, g_mem, g_xq, g_xk, w_xo):
    B, T, _ = hn.shape
    M = mem.shape[1]
    q = (hn @ w_xq).reshape(B, T, N_XATTN_HEADS, XATTN_HEAD_DIM)
    q = rmsnorm(q, g_xq)
    kv = rmsnorm(mem, g_mem) @ w_xkv
    k, v = jnp.split(kv, 2, axis=-1)
    k = rmsnorm(k.reshape(B, M, N_XATTN_HEADS, XATTN_HEAD_DIM), g_xk)
    v = v.reshape(B, M, N_XATTN_HEADS, XATTN_HEAD_DIM)
    logits = jnp.einsum('bthd,bmhd->bhtm', q, k).astype(jnp.float32) * (XATTN_HEAD_DIM ** -0.5)
    p = jax.nn.softmax(logits, axis=-1).astype(v.dtype)
    o = jnp.einsum('bhtm,bmhd->bthd', p, v).reshape(B, T, D_MODEL)
    return o @ w_xo


def setup_inputs(seed: int = 0) -> dict:
    key = jax.random.key(seed)
    ks = jax.random.split(key, 24)
    f32 = jnp.float32
    D = D_MODEL

    def w(k, shape, fan_in):
        return jax.random.normal(k, shape, f32) * fan_in ** -0.5

    def gain(k, shape):
        return 1.0 + 0.02 * jax.random.normal(k, shape, f32)

    return {
        "x": jax.random.normal(ks[0], (BATCH, SEQ, D), f32),
        "mem": jax.random.normal(ks[1], (BATCH, N_MEM, D), f32),
        "g_mix": gain(ks[2], (DEPTH, D)),
        "w_in": w(ks[3], (DEPTH, D, IN_WIDTH), D),
        "b_forget": jax.random.uniform(ks[4], (DEPTH, N_FOX_HEADS), f32, 1.0, 4.0),
        "g_ret_out": gain(ks[5], (DEPTH, N_RET_HEADS, HEAD_DIM)),
        "g_fox_q": gain(ks[6], (DEPTH, HEAD_DIM)),
        "g_fox_k": gain(ks[7], (DEPTH, HEAD_DIM)),
        "w_out": w(ks[8], (DEPTH, MIX_WIDTH, D), MIX_WIDTH),
        "g_xattn": gain(ks[9], (DEPTH, D)),
        "w_xq": w(ks[10], (DEPTH, D, D), D),
        "w_xkv": w(ks[11], (DEPTH, D, 2 * D), D),
        "g_mem": gain(ks[12], (DEPTH, D)),
        "g_xq": gain(ks[13], (DEPTH, XATTN_HEAD_DIM)),
        "g_xk": gain(ks[14], (DEPTH, XATTN_HEAD_DIM)),
        "w_xo": w(ks[15], (DEPTH, D, D), D),
        "g_ffn": gain(ks[16], (DEPTH, D)),
        "w_gate": w(ks[17], (DEPTH, D, D_FF), D),
        "w_up": w(ks[18], (DEPTH, D, D_FF), D),
        "w_down": w(ks[19], (DEPTH, D_FF, D), D_FF),
    }


def reference(x, mem, g_mix, w_in, b_forget, g_ret_out, g_fox_q, g_fox_k, w_out,
              g_xattn, w_xq, w_xkv, g_mem, g_xq, g_xk, w_xo,
              g_ffn, w_gate, w_up, w_down):
    B, T, _ = x.shape
    pos = jnp.arange(T, dtype=jnp.float32)
    splits = _split_points(IN_SIZES)
    h = x
    for l in range(DEPTH):
        hn = rmsnorm(h, g_mix[l])
        proj = hn @ w_in[l]
        rq, rk, rv, rg, fq, fk, fv, ff = jnp.split(proj, splits, axis=-1)

        rq = rotary(rq.reshape(B, T, N_RET_HEADS, HEAD_DIM), pos)
        rk = rotary(rk.reshape(B, T, N_RET_HEADS, HEAD_DIM), pos)
        ret = chunk_retention(rq, rk, rv.reshape(B, T, N_RET_HEADS, HEAD_DIM))
        ret = head_group_norm(ret, g_ret_out[l]).reshape(B, T, RET_WIDTH)
        ret = jax.nn.silu(rg) * ret

        fq = rmsnorm(fq.reshape(B, T, N_FOX_HEADS, HEAD_DIM), g_fox_q[l])
        fk = rmsnorm(fk.reshape(B, T, N_FOX_HEADS, HEAD_DIM), g_fox_k[l])
        log_f = jax.nn.log_sigmoid(ff.astype(jnp.float32) + b_forget[l].astype(jnp.float32))
        fox = forgetting_attention(fq, fk, fv.reshape(B, T, N_FOX_HEADS, HEAD_DIM), log_f)
        fox = fox.reshape(B, T, FOX_WIDTH)

        h = h + jnp.concatenate([ret, fox], axis=-1) @ w_out[l]

        h = h + memory_cross_attention(rmsnorm(h, g_xattn[l]), mem, w_xq[l], w_xkv[l],
                                       g_mem[l], g_xq[l], g_xk[l], w_xo[l])

        hn = rmsnorm(h, g_ffn[l])
        h = h + (jax.nn.silu(hn @ w_gate[l]) * (hn @ w_up[l])) @ w_down[l]
    return h
```

```cpp
#include <hip/hip_runtime.h>
#include <hip/hip_cooperative_groups.h>
#include <cstdio>
#include <cstdint>
namespace cg = cooperative_groups;
namespace pg8 {
#define PG8_LAS __attribute__((address_space(3)))
typedef unsigned short bf16_t;
typedef short bf16x8 __attribute__((ext_vector_type(8)));
typedef float f32x4 __attribute__((ext_vector_type(4)));
typedef unsigned u32x4 __attribute__((ext_vector_type(4)));
constexpr int BM = 256, BK = 64, HALF = 128, HTB = HALF * BK * 2  , STAGE_BYTES = 8 * HTB, NXCD = 8, WGM = 8;

__host__ __device__ __forceinline__ int lds_byte(int r, int c) { const int st = (r >> 4) * 2 + (c >> 5), rr = r & 15, cc = c & 31, ob = rr * 64 + cc * 2; return st * 1024 + (ob ^ (((ob >> 9) & 1) << 5)); }
__host__ __device__ __forceinline__ void stage_rc(int b, int& R, int& C) { const int st = b / 1024, sb = b % 1024, swz = sb ^ (((sb >> 9) & 1) << 5); R = (st >> 1) * 16 + swz / 64; C = (st & 1) * 32 + (swz % 64) / 2; }
__host__ __device__ __forceinline__ int perm32(int rho) { const int n = rho >> 4, i = rho & 15; return 8 * (i >> 2) + 4 * n + (i & 3); }

struct Unit { int pm, pn; };
struct Gemm { const bf16_t* A; const bf16_t* Bt; int M, N, K; };

struct StaticOrder {
    int nM, nN, nwg, G, c;
    __host__ __device__ void init(int M, int N, int G_, int c_) { nM = M / BM; nN = N / BM; nwg = nM * nN; G = G_; c = c_; }
    __host__ __device__ bool next(int i, Unit& u) const {
        const long L = (long)i * G + c; if (L >= nwg) return false;
        int wgid = (int)L; { const int q = nwg / NXCD, r = nwg % NXCD, xcd = wgid % NXCD, off = wgid / NXCD; wgid = (xcd < r ? xcd * (q + 1) : r * (q + 1) + (xcd - r) * q) + off; }
        const int nig = WGM * nN, gid = wgid / nig, fm = gid * WGM, gsz = (nM - fm) < WGM ? (nM - fm) : WGM;
        u.pm = fm + ((wgid % nig) % gsz); u.pn = (wgid % nig) / gsz; return true;
    }
    __device__ __forceinline__ void a_ready(const Unit&) const {}
    __device__ __forceinline__ void done(const Unit&) const {}
};

__device__ __forceinline__ unsigned cvt_pk_bf16(float lo, float hi) { unsigned r; asm volatile("v_cvt_pk_bf16_f32 %0, %1, %2" : "=v"(r) : "v"(lo), "v"(hi)); return r; }
typedef float f32x2 __attribute__((ext_vector_type(2)));
__device__ __forceinline__ f32x2 gelu_pk(f32x2 v) {
    const f32x2 av = __builtin_elementwise_abs(v), d = av * 0.2316418882f + 1.0f;
    f32x2 t; t.x = __builtin_amdgcn_rcpf(d.x); t.y = __builtin_amdgcn_rcpf(d.y);
    f32x2 q = t * 0.5307027145f + (-0.7265760135f); q = q * t + 0.7107068705f; q = q * t + (-0.142248368f); q = q * t + 0.127414796f; q = q * t;
    const f32x2 s = (v * v) * (-0.72134752044f);
    f32x2 e; e.x = __builtin_amdgcn_exp2f(s.x); e.y = __builtin_amdgcn_exp2f(s.y);
    const f32x2 m = v * (q * e), r = v - m;
    f32x2 o; o.x = v.x < 0.f ? m.x : r.x; o.y = v.y < 0.f ? m.y : r.y; return o;
}

template <int ACT  > struct EpiBf16 {
    static constexpr bool PERM = true, AFTER_DRAIN = false; static_assert(ACT == 0 || ACT == 1, "EpiBf16: ACT is 0 (none) or 1 (gelu_pk)");
    bf16_t* O; int ldc; const float* bias; int split_cols; size_t split_stride; float scale0;
    __device__ __forceinline__ void operator()(const f32x4 (&acc)[2][2][4][2], const Unit& u, int wr, int wc, int fr, int fq) const {
        const int row0 = u.pm * BM + wr * 64 + fr; int colt = u.pn * BM; bf16_t* base = O;
        float sc = 1.f; if (split_cols) { const int t = colt / split_cols; base += (size_t)t * split_stride; colt -= t * split_cols; if (t == 0) sc = scale0; }
        const int col0 = colt + wc * 32 + 8 * fq, bcol0 = u.pn * BM + wc * 32 + 8 * fq;
        f32x4 bv[2][2];
#pragma unroll
        for (int bj = 0; bj < 2; ++bj)
#pragma unroll
            for (int n = 0; n < 2; ++n) bv[bj][n] = bias ? *(const f32x4*)(bias + bcol0 + bj * HALF + 4 * n) : (f32x4){0.f, 0.f, 0.f, 0.f};
#pragma unroll
        for (int ai = 0; ai < 2; ++ai)
#pragma unroll
            for (int m = 0; m < 4; ++m) { bf16_t* rowp = base + (size_t)(row0 + ai * HALF + m * 16) * ldc + col0;
#pragma unroll
                for (int bj = 0; bj < 2; ++bj) { f32x4 v0 = acc[ai][bj][m][0] + bv[bj][0], v1 = acc[ai][bj][m][1] + bv[bj][1];
                    if (ACT == 1) { f32x2 a = gelu_pk((f32x2){v0[0], v0[1]}), b = gelu_pk((f32x2){v0[2], v0[3]}), c = gelu_pk((f32x2){v1[0], v1[1]}), d = gelu_pk((f32x2){v1[2], v1[3]});
                        v0 = (f32x4){a.x, a.y, b.x, b.y}; v1 = (f32x4){c.x, c.y, d.x, d.y}; }
                    v0 = v0 * sc; v1 = v1 * sc; u32x4 w; w.x = cvt_pk_bf16(v0[0], v0[1]); w.y = cvt_pk_bf16(v0[2], v0[3]); w.z = cvt_pk_bf16(v1[0], v1[1]); w.w = cvt_pk_bf16(v1[2], v1[3]);
                    *(u32x4*)(rowp + bj * HALF) = w; } }
    }
};

struct PanelStats {
    unsigned* xbuf;
    unsigned* cnt;
    unsigned* tmo;
    int ntn; float eps;
    unsigned code;
    __device__ __forceinline__ bool run(const f32x4 (&v)[2][2][4][2], const Unit& u, int wr, int wc, int fr, int fq, PG8_LAS unsigned char* lds, int wid, int lane) const {
        typedef float f32x2v __attribute__((ext_vector_type(2)));
        PG8_LAS f32x2v* P = (PG8_LAS f32x2v*)lds;
        PG8_LAS f32x2v* S = (PG8_LAS f32x2v*)(lds + 8192);
        PG8_LAS unsigned* flag = (PG8_LAS unsigned*)(lds + 8192 + 2048);
#pragma unroll
        for (int ai = 0; ai < 2; ++ai)
#pragma unroll
            for (int m = 0; m < 4; ++m) {
                float s = 0.f;
#pragma unroll
                for (int bj = 0; bj < 2; ++bj)
#pragma unroll
                    for (int n = 0; n < 2; ++n) { const f32x4 x = v[ai][bj][m][n]; s += (x[0] + x[1]) + (x[2] + x[3]); }
                s += __shfl_xor(s, 16); s += __shfl_xor(s, 32);
                const float mw = s * (1.0f / 64.0f); float q = 0.f;
#pragma unroll
                for (int bj = 0; bj < 2; ++bj)
#pragma unroll
                    for (int n = 0; n < 2; ++n) { const f32x4 d = v[ai][bj][m][n] - mw; q += (d[0] * d[0] + d[1] * d[1]) + (d[2] * d[2] + d[3] * d[3]); }
                q += __shfl_xor(q, 16); q += __shfl_xor(q, 32);
                if (fq == 0) P[(ai * HALF + wr * 64 + m * 16 + fr) * 4 + wc] = (f32x2v){mw, q};
            }
        asm volatile("s_waitcnt lgkmcnt(0)" ::: "memory"); __builtin_amdgcn_s_barrier(); asm volatile("" ::: "memory");
#if defined(BROKEN_EXCHANGE_NO_WAIT)
#warning BROKEN CONTROL BUILD: the row-statistics exchange does not wait; results are wrong by design
        if (blockIdx.x >= 64) { const long long t0_ = clock64(); while (clock64() - t0_ < 60000) __builtin_amdgcn_s_sleep(8); }
#endif
        const int row = wid * 32 + (lane & 31);
        if (lane < 32) {
            const f32x2v a = P[row * 4 + 0], b = P[row * 4 + 1], c = P[row * 4 + 2], d = P[row * 4 + 3];
            const float mt = (a.x + b.x + c.x + d.x) * 0.25f;
            const float da = a.x - mt, db = b.x - mt, dc = c.x - mt, dd = d.x - mt;
            const float m2 = (a.y + b.y) + (c.y + d.y) + 64.0f * ((da * da + db * db) + (dc * dc + dd * dd));
            unsigned long long* slot = (unsigned long long*)xbuf + ((size_t)(u.pm * BM + row) * 4 + u.pn);
            __hip_atomic_store(slot, ((unsigned long long)__float_as_uint(m2) << 32) | __float_as_uint(mt), __ATOMIC_RELAXED, __HIP_MEMORY_SCOPE_AGENT);
        }
        asm volatile("s_waitcnt vmcnt(0)" ::: "memory");
        if (lane == 0) __hip_atomic_fetch_add(cnt + 64 * u.pm, 1u, __ATOMIC_RELAXED, __HIP_MEMORY_SCOPE_AGENT);
        if (wid == 0) {
            bool dead = false; const unsigned long long t0 = __builtin_amdgcn_s_memrealtime(); const unsigned want = 8u * (unsigned)ntn;
            for (;;) {
#if defined(BROKEN_EXCHANGE_NO_WAIT)
                break;
#endif
                if ((unsigned)__builtin_amdgcn_readfirstlane(__hip_atomic_load(cnt + 64 * u.pm, __ATOMIC_RELAXED, __HIP_MEMORY_SCOPE_AGENT)) >= want) break;
                if (__builtin_amdgcn_s_memrealtime() - t0 > 2000000ull) {
                    if (lane == 0) { unsigned expect = 0u; __hip_atomic_compare_exchange_strong(tmo + 1, &expect, code | (unsigned)(u.pm & 0xff), __ATOMIC_RELAXED, __ATOMIC_RELAXED, __HIP_MEMORY_SCOPE_AGENT);
                                     __hip_atomic_store(tmo, 1u, __ATOMIC_RELAXED, __HIP_MEMORY_SCOPE_AGENT); }
                    dead = true; break; }
                __builtin_amdgcn_s_sleep(2);
            }
            __builtin_amdgcn_fence(__ATOMIC_ACQUIRE, "agent");
            if (lane == 0) flag[0] = dead ? 1u : 0u;
        }
        asm volatile("s_waitcnt vmcnt(0) lgkmcnt(0)" ::: "memory"); __builtin_amdgcn_s_barrier(); asm volatile("" ::: "memory");
        const bool bad = flag[0] != 0u;
        if (lane < 32) {
            const unsigned long long* slot = (const unsigned long long*)xbuf + (size_t)(u.pm * BM + row) * 4; float mt[4], m2[4]; float ms = 0.f;
#pragma unroll
            for (int t = 0; t < 4; ++t) { if (t < ntn) { const unsigned long long w = __hip_atomic_load(slot + t, __ATOMIC_RELAXED, __HIP_MEMORY_SCOPE_AGENT); mt[t] = __uint_as_float((unsigned)w); m2[t] = __uint_as_float((unsigned)(w >> 32)); } else { mt[t] = 0.f; m2[t] = 0.f; } ms += mt[t]; }
            const float mean = ms / (float)ntn; float q = 0.f;
#pragma unroll
            for (int t = 0; t < 4; ++t) if (t < ntn) { const float dm = mt[t] - mean; q += m2[t] + 256.0f * dm * dm; }
            S[row] = (f32x2v){mean, 1.0f / sqrtf(q / (256.0f * (float)ntn) + eps)};
        }
        asm volatile("s_waitcnt lgkmcnt(0)" ::: "memory"); __builtin_amdgcn_s_barrier(); asm volatile("" ::: "memory");
        return bad;
    }
};
struct EpiLnRes {
    static constexpr bool PERM = false, AFTER_DRAIN = true;
    const float* base; float* out; int ldc; const float* bias; PanelStats st; unsigned poison;
    __device__ __forceinline__ void fused(f32x4 (&acc)[2][2][4][2], const Unit& u, int wr, int wc, int fr, int fq, PG8_LAS unsigned char* lds, int wid, int lane) const {
        typedef float f32x2v __attribute__((ext_vector_type(2)));
        const PG8_LAS f32x2v* S = (const PG8_LAS f32x2v*)(lds + 8192);
        const int col0 = u.pn * BM + wc * 32 + 4 * fq;
#pragma unroll
        for (int bj = 0; bj < 2; ++bj)
#pragma unroll
            for (int n = 0; n < 2; ++n) { const f32x4 bv = bias ? *(const f32x4*)(bias + col0 + bj * HALF + n * 16) : (f32x4){0.f, 0.f, 0.f, 0.f};
#pragma unroll
                for (int ai = 0; ai < 2; ++ai)
#pragma unroll
                    for (int m = 0; m < 4; ++m) acc[ai][bj][m][n] += bv; }
        f32x4 pre[4][2][2];
#pragma unroll
        for (int m = 0; m < 4; ++m) { const size_t off = (size_t)(u.pm * BM + wr * 64 + m * 16 + fr) * ldc + col0;
#pragma unroll
            for (int bj = 0; bj < 2; ++bj)
#pragma unroll
                for (int n = 0; n < 2; ++n) pre[m][bj][n] = *(const f32x4*)(base + off + bj * HALF + n * 16); }
        const bool bad = st.run(acc, u, wr, wc, fr, fq, lds, wid, lane) || poison != 0u;
        const float qnan = __builtin_nanf("");
#pragma unroll
        for (int ai = 0; ai < 2; ++ai)
#pragma unroll
            for (int m = 0; m < 4; ++m) { const int r = ai * HALF + wr * 64 + m * 16 + fr; const f32x2v sr = S[r]; const size_t off = (size_t)(u.pm * BM + r) * ldc + col0;
#pragma unroll
                for (int bj = 0; bj < 2; ++bj)
#pragma unroll
                    for (int n = 0; n < 2; ++n) { const f32x4 bs = ai == 0 ? pre[m][bj][n] : *(const f32x4*)(base + off + bj * HALF + n * 16); f32x4 o = bs + (acc[ai][bj][m][n] - sr.x) * sr.y;
                        if (bad) o = (f32x4){qnan, qnan, qnan, qnan}; *(f32x4*)(out + off + bj * HALF + n * 16) = o; }
                if (m & 1) asm volatile("" ::: "memory"); }
    }
};
struct EpiLnResLn {
    static constexpr bool PERM = false, AFTER_DRAIN = true;
    const float* base; float* out; bf16_t* xn; int ldc; const float* bias; PanelStats st1, st2; unsigned poison;
    __device__ __forceinline__ void fused(f32x4 (&acc)[2][2][4][2], const Unit& u, int wr, int wc, int fr, int fq, PG8_LAS unsigned char* lds, int wid, int lane) const {
        typedef float f32x2v __attribute__((ext_vector_type(2))); typedef unsigned u32x2v __attribute__((ext_vector_type(2)));
        const PG8_LAS f32x2v* S = (const PG8_LAS f32x2v*)(lds + 8192);
        const int col0 = u.pn * BM + wc * 32 + 4 * fq;
#pragma unroll
        for (int bj = 0; bj < 2; ++bj)
#pragma unroll
            for (int n = 0; n < 2; ++n) { const f32x4 bv = bias ? *(const f32x4*)(bias + col0 + bj * HALF + n * 16) : (f32x4){0.f, 0.f, 0.f, 0.f};
#pragma unroll
                for (int ai = 0; ai < 2; ++ai)
#pragma unroll
                    for (int m = 0; m < 4; ++m) acc[ai][bj][m][n] += bv; }
        bool bad = st1.run(acc, u, wr, wc, fr, fq, lds, wid, lane) || poison != 0u;
        const float qnan = __builtin_nanf("");
#pragma unroll
        for (int ai = 0; ai < 2; ++ai)
#pragma unroll
            for (int m = 0; m < 4; ++m) { const int r = ai * HALF + wr * 64 + m * 16 + fr; const f32x2v sr = S[r]; const size_t off = (size_t)(u.pm * BM + r) * ldc + col0;
#pragma unroll
                for (int bj = 0; bj < 2; ++bj)
#pragma unroll
                    for (int n = 0; n < 2; ++n) { const f32x4 bs = *(const f32x4*)(base + off + bj * HALF + n * 16); acc[ai][bj][m][n] = bs + (acc[ai][bj][m][n] - sr.x) * sr.y; }
                asm volatile("" : "+v"(acc[ai][0][m][0]), "+v"(acc[ai][0][m][1]), "+v"(acc[ai][1][m][0]), "+v"(acc[ai][1][m][1]));
                if (m & 1) asm volatile("" ::: "memory"); }
        const bool bad1 = bad;
        bad = st2.run(acc, u, wr, wc, fr, fq, lds, wid, lane) || bad;
#pragma unroll
        for (int ai = 0; ai < 2; ++ai)
#pragma unroll
            for (int m = 0; m < 4; ++m) { const int r = ai * HALF + wr * 64 + m * 16 + fr; const f32x2v sr = S[r]; const size_t off = (size_t)(u.pm * BM + r) * ldc + col0;
#pragma unroll
                for (int bj = 0; bj < 2; ++bj)
#pragma unroll
                    for (int n = 0; n < 2; ++n) { const f32x4 x1 = acc[ai][bj][m][n]; *(f32x4*)(out + off + bj * HALF + n * 16) = bad1 ? (f32x4){qnan, qnan, qnan, qnan} : x1;
                        const f32x4 o = (x1 - sr.x) * sr.y; u32x2v w; w.x = cvt_pk_bf16(o[0], o[1]); w.y = cvt_pk_bf16(o[2], o[3]);
                        if (bad) { w.x = 0x7fc07fc0u; w.y = 0x7fc07fc0u; } *(u32x2v*)(xn + off + bj * HALF + n * 16) = w; }
                asm volatile("" ::: "memory"); }
    }
};

template <class Epi, class Sched, bool ALIGN_EPI = false, bool SP2 = false>
__device__ __forceinline__ void gemm_phase(PG8_LAS unsigned char* lds, const Gemm g, const Sched& S, const Epi& E) {
    const int tid = threadIdx.x, wid = __builtin_amdgcn_readfirstlane(tid >> 6), lane = tid & 63, wr = wid >> 2, wc = wid & 3, fr = lane & 15, fq = lane >> 4;
    const int K = g.K, nt = K / BK;
    unsigned voffA[2], voffB[2];
#pragma unroll
    for (int i = 0; i < 2; ++i) { int R, C; stage_rc(tid * 16 + i * 8192, R, C); const int Rb = Epi::PERM ? ((R & ~31) + perm32(R & 31)) : R;
        voffA[i] = (unsigned)(R * K + C) * 2u; voffB[i] = (unsigned)(Rb * K + C) * 2u; }
    const size_t kstep = (size_t)(BK * 2);
    const size_t hstep = (size_t)HALF * K * 2;
    const size_t tstep = 2 * hstep;
    const unsigned ldsw = (unsigned)wid * 1024u;
    const int aoff = lds_byte(wr * 64 + fr, fq * 8), boff = lds_byte(wc * 32 + fr, fq * 8);
#define PG8_SA(b, h) (((b) * 2 + (h)) * HTB)
#define PG8_SB(b, h) ((4 + (b) * 2 + (h)) * HTB)
#define PG8_STAGE(bufoff, gbase, voff) do { _Pragma("unroll") for (int _i = 0; _i < 2; ++_i) \
        __builtin_amdgcn_global_load_lds((const unsigned*)((const char*)(gbase) + (voff)[_i]), (PG8_LAS unsigned*)(lds + (bufoff) + ldsw + _i * 8192), 16, 0, 0); } while (0)
#define PG8_LDA(dst, b, h) do { _Pragma("unroll") for (int m = 0; m < 4; ++m) _Pragma("unroll") for (int k = 0; k < 2; ++k) dst[m][k] = *(const PG8_LAS bf16x8*)(lds + PG8_SA(b, h) + aoff + m * 2048 + k * 1024); } while (0)
#define PG8_LDB(dst, b, h) do { _Pragma("unroll") for (int n = 0; n < 2; ++n) _Pragma("unroll") for (int k = 0; k < 2; ++k) dst[n][k] = *(const PG8_LAS bf16x8*)(lds + PG8_SB(b, h) + boff + n * 2048 + k * 1024); } while (0)
#define PG8_MMA(ai, bj, At, Bt) do { __builtin_amdgcn_s_setprio(1); _Pragma("unroll") for (int m = 0; m < 4; ++m) _Pragma("unroll") for (int n = 0; n < 2; ++n) _Pragma("unroll") for (int k = 0; k < 2; ++k) \
        acc[ai][bj][m][n] = __builtin_amdgcn_mfma_f32_16x16x32_bf16(Bt[n][k], At[m][k], acc[ai][bj][m][n], 0, 0, 0); __builtin_amdgcn_s_setprio(0); } while (0)
#define PG8_WAIT_V(n) asm volatile("s_waitcnt vmcnt(" #n ")" ::: "memory")
#define PG8_WAIT_L(n) asm volatile("s_waitcnt lgkmcnt(" #n ")" ::: "memory")
#define PG8_BAR __builtin_amdgcn_s_barrier()
#define PG8_SCHED __builtin_amdgcn_sched_barrier(0)
    Unit cur, nxt; int ui = 0;
    if (!S.next(0, cur)) return;
    f32x4 acc[2][2][4][2];
#pragma unroll
    for (int a = 0; a < 2; ++a)
#pragma unroll
        for (int b = 0; b < 2; ++b)
#pragma unroll
            for (int m = 0; m < 4; ++m)
#pragma unroll
                for (int n = 0; n < 2; ++n) acc[a][b][m][n] = (f32x4){0.f, 0.f, 0.f, 0.f};
    bf16x8 At[4][2], B0[2][2], B1[2][2];
    const char* cA = (const char*)g.A + (size_t)cur.pm * tstep; const char* cB = (const char*)g.Bt + (size_t)cur.pn * tstep;
    S.a_ready(cur);
    if constexpr (SP2) {
        PG8_STAGE(PG8_SB(0, 0), cB, voffB); PG8_STAGE(PG8_SB(0, 1), cB + hstep, voffB); PG8_STAGE(PG8_SA(0, 0), cA, voffA); PG8_STAGE(PG8_SA(0, 1), cA + hstep, voffA);
        if (wr == 1) PG8_BAR;
        PG8_WAIT_V(2); PG8_BAR;
        PG8_STAGE(PG8_SB(1, 0), cB + kstep, voffB); PG8_STAGE(PG8_SA(1, 0), cA + kstep, voffA); PG8_STAGE(PG8_SB(1, 1), cB + hstep + kstep, voffB);
        PG8_WAIT_V(6); PG8_BAR;
    } else {
        PG8_STAGE(PG8_SB(0, 0), cB, voffB); PG8_STAGE(PG8_SA(0, 0), cA, voffA); PG8_STAGE(PG8_SB(0, 1), cB + hstep, voffB); PG8_STAGE(PG8_SA(0, 1), cA + hstep, voffA);
        if (wr == 1) PG8_BAR;
        PG8_WAIT_V(4); PG8_BAR;
        PG8_STAGE(PG8_SB(1, 0), cB + kstep, voffB); PG8_STAGE(PG8_SA(1, 0), cA + kstep, voffA); PG8_STAGE(PG8_SB(1, 1), cB + hstep + kstep, voffB);
        PG8_WAIT_V(6); PG8_BAR;
    }
    for (;;) {
        const bool has_next = S.next(ui + 1, nxt);
        const char* nA = has_next ? (const char*)g.A + (size_t)nxt.pm * tstep : cA; const char* nB = has_next ? (const char*)g.Bt + (size_t)nxt.pn * tstep : cB;
        for (int t = 0; t < nt; t += 2) {
            const bool last = (t == nt - 2);
            const char* a1 = cA + (size_t)(t + 1) * kstep;
            const char* a2 = last ? nA : cA + (size_t)(t + 2) * kstep; const char* b2 = last ? nB : cB + (size_t)(t + 2) * kstep;
            const char* a3 = a2 + kstep; const char* b3 = b2 + kstep;
            if (last && has_next) S.a_ready(nxt);
            if constexpr (SP2) {
            PG8_LDB(B0, 0, 0); PG8_LDB(B1, 0, 1); PG8_SCHED; PG8_LDA(At, 0, 0); PG8_STAGE(PG8_SA(1, 1), a1 + hstep, voffA);
            PG8_WAIT_V(8); PG8_WAIT_L(0); PG8_BAR; PG8_MMA(0, 0, At, B0); PG8_MMA(0, 1, At, B1); PG8_BAR; PG8_SCHED;
            PG8_LDA(At, 0, 1); PG8_STAGE(PG8_SB(0, 0), b2, voffB); PG8_STAGE(PG8_SB(0, 1), b2 + hstep, voffB); PG8_STAGE(PG8_SA(0, 0), a2, voffA);
            PG8_WAIT_V(8); PG8_WAIT_L(0); PG8_BAR; PG8_MMA(1, 0, At, B0); PG8_MMA(1, 1, At, B1); PG8_BAR; PG8_SCHED;
            PG8_LDB(B0, 1, 0); PG8_LDB(B1, 1, 1); PG8_SCHED; PG8_LDA(At, 1, 0); PG8_STAGE(PG8_SA(0, 1), a2 + hstep, voffA);
            PG8_WAIT_V(8); PG8_WAIT_L(0); PG8_BAR; PG8_MMA(0, 0, At, B0); PG8_MMA(0, 1, At, B1); PG8_BAR; PG8_SCHED;
            PG8_LDA(At, 1, 1); PG8_STAGE(PG8_SB(1, 0), b3, voffB); PG8_STAGE(PG8_SB(1, 1), b3 + hstep, voffB); PG8_STAGE(PG8_SA(1, 0), a3, voffA);
            PG8_WAIT_V(8); PG8_WAIT_L(0); PG8_BAR; PG8_MMA(1, 0, At, B0); PG8_MMA(1, 1, At, B1); PG8_BAR; PG8_SCHED;
            } else {
            PG8_LDB(B0, 0, 0); PG8_SCHED; PG8_LDA(At, 0, 0); PG8_STAGE(PG8_SA(1, 1), a1 + hstep, voffA);
            PG8_WAIT_L(8); PG8_BAR; PG8_WAIT_L(0); PG8_MMA(0, 0, At, B0); PG8_BAR; PG8_SCHED;
            PG8_LDB(B1, 0, 1); PG8_STAGE(PG8_SB(0, 0), b2, voffB);
            PG8_BAR; PG8_WAIT_L(0); PG8_MMA(0, 1, At, B1); PG8_BAR;
            PG8_LDA(At, 0, 1); PG8_STAGE(PG8_SA(0, 0), a2, voffA);
            PG8_BAR; PG8_WAIT_L(0); PG8_MMA(1, 0, At, B0); PG8_BAR; PG8_SCHED;
            PG8_STAGE(PG8_SB(0, 1), b2 + hstep, voffB);
            PG8_WAIT_V(6); PG8_BAR; PG8_MMA(1, 1, At, B1); PG8_BAR;
            PG8_LDB(B0, 1, 0); PG8_SCHED; PG8_LDA(At, 1, 0); PG8_STAGE(PG8_SA(0, 1), a2 + hstep, voffA);
            PG8_WAIT_L(8); PG8_BAR; PG8_WAIT_L(0); PG8_MMA(0, 0, At, B0); PG8_BAR; PG8_SCHED;
            PG8_LDB(B1, 1, 1); PG8_STAGE(PG8_SB(1, 0), b3, voffB);
            PG8_BAR; PG8_WAIT_L(0); PG8_MMA(0, 1, At, B1); PG8_BAR;
            PG8_LDA(At, 1, 1); PG8_STAGE(PG8_SA(1, 0), a3, voffA);
            PG8_BAR; PG8_WAIT_L(0); PG8_MMA(1, 0, At, B0); PG8_BAR; PG8_SCHED;
            PG8_STAGE(PG8_SB(1, 1), b3 + hstep, voffB);
            PG8_WAIT_V(6); PG8_BAR; PG8_MMA(1, 1, At, B1); PG8_BAR;
            }
        }
        if constexpr (ALIGN_EPI) { if (wr == 0) PG8_BAR; }
        if constexpr (!Epi::AFTER_DRAIN) { E(acc, cur, wr, wc, fr, fq); S.done(cur); }
        if (!has_next) break;
#pragma unroll
        for (int a = 0; a < 2; ++a)
#pragma unroll
            for (int b = 0; b < 2; ++b)
#pragma unroll
                for (int m = 0; m < 4; ++m)
#pragma unroll
                    for (int n = 0; n < 2; ++n) acc[a][b][m][n] = (f32x4){0.f, 0.f, 0.f, 0.f};
        cur = nxt; cA = nA; cB = nB; ++ui;
        if constexpr (ALIGN_EPI) { if (wr == 1) PG8_BAR; }
    }
    PG8_WAIT_V(0);
    if constexpr (!ALIGN_EPI) { if (wr == 0) PG8_BAR; }
    PG8_BAR;
    if constexpr (Epi::AFTER_DRAIN) { E.fused(acc, cur, wr, wc, fr, fq, lds, wid, lane); S.done(cur); }
#undef PG8_SA
#undef PG8_SB
#undef PG8_STAGE
#undef PG8_LDA
#undef PG8_LDB
#undef PG8_MMA
#undef PG8_WAIT_V
#undef PG8_WAIT_L
#undef PG8_BAR
#undef PG8_SCHED
}
}
constexpr int BATCH = 4, SEQ = 4096, DM = 1024, MROWS = BATCH * SEQ;
constexpr int NMEM = 256, MEMROWS = BATCH * NMEM;
constexpr int PP = 3584;
constexpr int INW = 3592, DFF = 2816;
constexpr int C_RQ = 0, C_RK = 512, C_RV = 1024, C_RG = 1536, C_FQ = 2048, C_FK = 2560, C_FV = 3072;
constexpr float EPS = 1e-6f, LOG2E = 1.4426950408889634f;
constexpr float C2F = 0.125f * LOG2E;
constexpr int NTHR = 512, NWAVES = 8;
constexpr int LDS_BYTES = 147456;

constexpr size_t MiB = 1u << 20;
constexpr size_t WS_WIN = 2 * MiB, WS_WOUT = 10 * MiB, WS_WXQ = 12 * MiB, WS_WXKV = 14 * MiB, WS_WXO = 18 * MiB, WS_WGU = 20 * MiB, WS_WD = 32 * MiB;
constexpr size_t WS_COS = 38 * MiB, WS_SIN = 38 * MiB + 512 * 1024, WS_LOGF = 39 * MiB, WS_FC = 39 * MiB + 512 * 1024;
constexpr size_t WS_MEMN = 40 * MiB, WS_KVM = 42 * MiB, WS_KSS = 46 * MiB, WS_SS1 = 47 * MiB, WS_QSS = 48 * MiB, WS_SS2 = 49 * MiB;
constexpr size_t WS_HN = 64 * MiB;
constexpr size_t WS_P = 96 * MiB;
constexpr size_t WS_KVT = 208 * MiB;
constexpr size_t WS_ST = 240 * MiB;
constexpr size_t WS_H1B = 96 * MiB;
constexpr size_t WS_QX = 128 * MiB;
constexpr size_t WS_O = 160 * MiB;
constexpr size_t WS_ACT = 128 * MiB;
constexpr size_t WS_END = 256 * MiB;

typedef unsigned short bf16_t;
typedef short bf16x8 __attribute__((ext_vector_type(8)));
typedef short s16x4 __attribute__((ext_vector_type(4)));
typedef float f32x4 __attribute__((ext_vector_type(4)));
typedef float f32x16 __attribute__((ext_vector_type(16)));
typedef unsigned u32x4 __attribute__((ext_vector_type(4)));
typedef unsigned u32x2 __attribute__((ext_vector_type(2)));
#define LAS __attribute__((address_space(3)))
typedef LAS unsigned char* ldsp_t;

__device__ __forceinline__ unsigned pkbf(float lo, float hi) {
    typedef float f2 __attribute__((ext_vector_type(2))); typedef __bf16 b2 __attribute__((ext_vector_type(2)));
    f2 v = {lo, hi}; b2 b = __builtin_convertvector(v, b2); return __builtin_bit_cast(unsigned, b);
}
__device__ __forceinline__ float bflo(unsigned u) { return __uint_as_float(u << 16); }
__device__ __forceinline__ float bfhi(unsigned u) { return __uint_as_float(u & 0xffff0000u); }
__device__ __forceinline__ int crow(int r, int hi) { return (r & 3) + 8 * (r >> 2) + 4 * hi; }
__device__ __forceinline__ float wave_sum(float v) {
#pragma unroll
    for (int o = 1; o < 64; o <<= 1) v += __shfl_xor(v, o);
    return v;
}
__device__ __forceinline__ s16x4 tr_rd(ldsp_t p) {
    typedef short v4i16_t __attribute__((ext_vector_type(4)));
    return __builtin_bit_cast(s16x4, __builtin_amdgcn_ds_read_tr16_b64_v4i16((LAS v4i16_t*)p));
}
__device__ __forceinline__ bf16x8 cat8(s16x4 lo, s16x4 hi) { return __builtin_shufflevector(lo, hi, 0, 1, 2, 3, 4, 5, 6, 7); }
#define MFMA32(a, b, c) __builtin_amdgcn_mfma_f32_32x32x16_bf16((a), (b), (c), 0, 0, 0)
__device__ __forceinline__ bf16x8 pack8(const f32x16& x, int s) {
    u32x4 p; p.x = pkbf(x[8 * s], x[8 * s + 1]); p.y = pkbf(x[8 * s + 2], x[8 * s + 3]); p.z = pkbf(x[8 * s + 4], x[8 * s + 5]); p.w = pkbf(x[8 * s + 6], x[8 * s + 7]);
    return __builtin_bit_cast(bf16x8, p);
}

namespace pg8 {
struct EpiProj {
    static constexpr bool PERM = true, AFTER_DRAIN = false;
    bf16_t* P; const float* cs; const float* sn; const float* gq; const float* gk;
    __device__ __forceinline__ void operator()(const f32x4 (&acc)[2][2][4][2], const Unit& u, int wr, int wc, int fr, int fq) const {
        const int seg = u.pn >> 1;
        const int row0 = u.pm * BM + wr * 64 + fr;
        const int colbase = u.pn * 256 + 64 * wc + 8 * fq;
        if (seg == 0 || seg == 1) {
#pragma unroll
            for (int ai = 0; ai < 2; ++ai)
#pragma unroll
                for (int m = 0; m < 4; ++m) {
                    const int row = row0 + ai * HALF + m * 16; const int pos = row & (SEQ - 1);
                    const float* cp = cs + pos * 32 + 8 * fq; const float* sp = sn + pos * 32 + 8 * fq;
                    u32x4 w1, w2;
                    { const f32x4 c = *(const f32x4*)cp, s = *(const f32x4*)sp; const f32x4 x1 = acc[ai][0][m][0], x2 = acc[ai][1][m][0];
                      const f32x4 o1 = x1 * c - x2 * s, o2 = x1 * s + x2 * c; w1.x = pkbf(o1[0], o1[1]); w1.y = pkbf(o1[2], o1[3]); w2.x = pkbf(o2[0], o2[1]); w2.y = pkbf(o2[2], o2[3]); }
                    { const f32x4 c = *(const f32x4*)(cp + 4), s = *(const f32x4*)(sp + 4); const f32x4 x1 = acc[ai][0][m][1], x2 = acc[ai][1][m][1];
                      const f32x4 o1 = x1 * c - x2 * s, o2 = x1 * s + x2 * c; w1.z = pkbf(o1[0], o1[1]); w1.w = pkbf(o1[2], o1[3]); w2.z = pkbf(o2[0], o2[1]); w2.w = pkbf(o2[2], o2[3]); }
                    bf16_t* rp = P + (size_t)row * PP + colbase;
                    *(u32x4*)rp = w1; *(u32x4*)(rp + 32) = w2;
                }
        } else if (seg == 4 || seg == 5) {
            const float* g = (seg == 4) ? gq : gk; const float sc = (seg == 4) ? C2F : 1.0f;
            f32x4 gv[2][2];
#pragma unroll
            for (int bj = 0; bj < 2; ++bj)
#pragma unroll
                for (int n = 0; n < 2; ++n) gv[bj][n] = *(const f32x4*)(g + 32 * bj + 8 * fq + 4 * n);
#pragma unroll
            for (int ai = 0; ai < 2; ++ai)
#pragma unroll
                for (int m = 0; m < 4; ++m) {
                    const int row = row0 + ai * HALF + m * 16;
                    float ss = 0.f;
#pragma unroll
                    for (int bj = 0; bj < 2; ++bj)
#pragma unroll
                        for (int n = 0; n < 2; ++n) { const f32x4 x = acc[ai][bj][m][n]; ss += (x[0] * x[0] + x[1] * x[1]) + (x[2] * x[2] + x[3] * x[3]); }
                    ss += __shfl_xor(ss, 16); ss += __shfl_xor(ss, 32);
                    const float rs = rsqrtf(ss * (1.0f / 64.0f) + EPS) * sc;
                    bf16_t* rp = P + (size_t)row * PP + colbase;
#pragma unroll
                    for (int bj = 0; bj < 2; ++bj) { const f32x4 a = acc[ai][bj][m][0] * gv[bj][0] * rs, b = acc[ai][bj][m][1] * gv[bj][1] * rs;
                        u32x4 w; w.x = pkbf(a[0], a[1]); w.y = pkbf(a[2], a[3]); w.z = pkbf(b[0], b[1]); w.w = pkbf(b[2], b[3]); *(u32x4*)(rp + 32 * bj) = w; }
                }
        } else {
#pragma unroll
            for (int ai = 0; ai < 2; ++ai)
#pragma unroll
                for (int m = 0; m < 4; ++m) {
                    const int row = row0 + ai * HALF + m * 16; bf16_t* rp = P + (size_t)row * PP + colbase;
#pragma unroll
                    for (int bj = 0; bj < 2; ++bj) { const f32x4 a = acc[ai][bj][m][0], b = acc[ai][bj][m][1];
                        u32x4 w; w.x = pkbf(a[0], a[1]); w.y = pkbf(a[2], a[3]); w.z = pkbf(b[0], b[1]); w.w = pkbf(b[2], b[3]); *(u32x4*)(rp + 32 * bj) = w; }
                }
        }
    }
};
struct EpiKV {
    static constexpr bool PERM = true, AFTER_DRAIN = false;
    bf16_t* O; float* kss; const float* gxq; const float* gxk;
    __device__ __forceinline__ void operator()(const f32x4 (&acc)[2][2][4][2], const Unit& u, int wr, int wc, int fr, int fq) const {
        const int row0 = u.pm * BM + wr * 64 + fr; const int col0 = u.pn * BM + wc * 32 + 8 * fq; const bool isk = u.pn < 4;
        f32x4 gv[2][2];
#pragma unroll
        for (int bj = 0; bj < 2; ++bj)
#pragma unroll
            for (int n = 0; n < 2; ++n) { const int c = (col0 + bj * HALF + 4 * n) & 255;
                gv[bj][n] = isk ? (*(const f32x4*)(gxq + c)) * (*(const f32x4*)(gxk + c)) : (f32x4){1.f, 1.f, 1.f, 1.f}; }
#pragma unroll
        for (int ai = 0; ai < 2; ++ai)
#pragma unroll
            for (int m = 0; m < 4; ++m) {
                const int row = row0 + ai * HALF + m * 16; float ss = 0.f;
                bf16_t* rp = O + (size_t)row * 2048 + col0;
#pragma unroll
                for (int bj = 0; bj < 2; ++bj) { const f32x4 a0 = acc[ai][bj][m][0], b0 = acc[ai][bj][m][1];
                    ss += (a0[0] * a0[0] + a0[1] * a0[1]) + (a0[2] * a0[2] + a0[3] * a0[3]) + (b0[0] * b0[0] + b0[1] * b0[1]) + (b0[2] * b0[2] + b0[3] * b0[3]);
                    const f32x4 a = a0 * gv[bj][0], b = b0 * gv[bj][1];
                    u32x4 w; w.x = pkbf(a[0], a[1]); w.y = pkbf(a[2], a[3]); w.z = pkbf(b[0], b[1]); w.w = pkbf(b[2], b[3]); *(u32x4*)(rp + bj * HALF) = w; }
                ss += __shfl_xor(ss, 16); ss += __shfl_xor(ss, 32);
                if (isk && fq == 0) kss[(size_t)row * 16 + u.pn * 4 + wc] = ss;
            }
    }
};
struct EpiRes {
    static constexpr bool PERM = true, AFTER_DRAIN = false;
    const float* base; float* out; bf16_t* hb; float* ssp;
    __device__ __forceinline__ void operator()(const f32x4 (&acc)[2][2][4][2], const Unit& u, int wr, int wc, int fr, int fq) const {
        const int row0 = u.pm * BM + wr * 64 + fr; const int col0 = u.pn * BM + wc * 32 + 8 * fq;
#pragma unroll
        for (int ai = 0; ai < 2; ++ai)
#pragma unroll
            for (int m = 0; m < 4; ++m) {
                const int row = row0 + ai * HALF + m * 16; float ss = 0.f; const size_t off = (size_t)row * DM + col0;
#pragma unroll
                for (int bj = 0; bj < 2; ++bj) {
                    const f32x4 a = *(const f32x4*)(base + off + bj * HALF) + acc[ai][bj][m][0], b = *(const f32x4*)(base + off + bj * HALF + 4) + acc[ai][bj][m][1];
                    *(f32x4*)(out + off + bj * HALF) = a; *(f32x4*)(out + off + bj * HALF + 4) = b;
                    ss += (a[0] * a[0] + a[1] * a[1]) + (a[2] * a[2] + a[3] * a[3]) + (b[0] * b[0] + b[1] * b[1]) + (b[2] * b[2] + b[3] * b[3]);
                    if (hb) { u32x4 w; w.x = pkbf(a[0], a[1]); w.y = pkbf(a[2], a[3]); w.z = pkbf(b[0], b[1]); w.w = pkbf(b[2], b[3]); *(u32x4*)(hb + off + bj * HALF) = w; }
                }
                if (ssp) { ss += __shfl_xor(ss, 16); ss += __shfl_xor(ss, 32); if (fq == 0) ssp[(size_t)row * 16 + u.pn * 4 + wc] = ss; }
            }
    }
};
struct EpiXq {
    static constexpr bool PERM = true, AFTER_DRAIN = false;
    bf16_t* O; float* qss;
    __device__ __forceinline__ void operator()(const f32x4 (&acc)[2][2][4][2], const Unit& u, int wr, int wc, int fr, int fq) const {
        const int row0 = u.pm * BM + wr * 64 + fr; const int col0 = u.pn * BM + wc * 32 + 8 * fq;
#pragma unroll
        for (int ai = 0; ai < 2; ++ai)
#pragma unroll
            for (int m = 0; m < 4; ++m) {
                const int row = row0 + ai * HALF + m * 16; float ss = 0.f; bf16_t* rp = O + (size_t)row * DM + col0;
#pragma unroll
                for (int bj = 0; bj < 2; ++bj) { const f32x4 a = acc[ai][bj][m][0], b = acc[ai][bj][m][1];
                    ss += (a[0] * a[0] + a[1] * a[1]) + (a[2] * a[2] + a[3] * a[3]) + (b[0] * b[0] + b[1] * b[1]) + (b[2] * b[2] + b[3] * b[3]);
                    u32x4 w; w.x = pkbf(a[0], a[1]); w.y = pkbf(a[2], a[3]); w.z = pkbf(b[0], b[1]); w.w = pkbf(b[2], b[3]); *(u32x4*)(rp + bj * HALF) = w; }
                ss += __shfl_xor(ss, 16); ss += __shfl_xor(ss, 32);
                if (fq == 0) qss[(size_t)row * 16 + u.pn * 4 + wc] = ss;
            }
    }
};
struct EpiGU {
    static constexpr bool PERM = true, AFTER_DRAIN = false;
    bf16_t* A; const float* ss2;
    __device__ __forceinline__ void operator()(const f32x4 (&acc)[2][2][4][2], const Unit& u, int wr, int wc, int fr, int fq) const {
        const int row0 = u.pm * BM + wr * 64 + fr; const int col0 = u.pn * 128 + wc * 32 + 8 * fq;
#pragma unroll
        for (int ai = 0; ai < 2; ++ai)
#pragma unroll
            for (int m = 0; m < 4; ++m) {
                const int row = row0 + ai * HALF + m * 16;
                const f32x4* sp = (const f32x4*)(ss2 + (size_t)row * 16); const f32x4 s0 = sp[0], s1 = sp[1], s2 = sp[2], s3 = sp[3];
                const float tot = ((s0[0] + s0[1]) + (s0[2] + s0[3])) + ((s1[0] + s1[1]) + (s1[2] + s1[3])) + ((s2[0] + s2[1]) + (s2[2] + s2[3])) + ((s3[0] + s3[1]) + (s3[2] + s3[3]));
                const float r = rsqrtf(tot * (1.0f / 1024.0f) + EPS);
                float o[8];
#pragma unroll
                for (int n = 0; n < 2; ++n)
#pragma unroll
                    for (int e = 0; e < 4; ++e) { const float g = acc[ai][0][m][n][e] * r, up = acc[ai][1][m][n][e] * r;
                        o[4 * n + e] = g * __builtin_amdgcn_rcpf(1.0f + __builtin_amdgcn_exp2f(-g * LOG2E)) * up; }
                u32x4 w; w.x = pkbf(o[0], o[1]); w.y = pkbf(o[2], o[3]); w.z = pkbf(o[4], o[5]); w.w = pkbf(o[6], o[7]);
                *(u32x4*)(A + (size_t)row * DFF + col0) = w;
            }
    }
};
}

__device__ __forceinline__ void transpose_item(const float* __restrict__ W, int ldw, int src_col0, const float* __restrict__ gain, bf16_t* __restrict__ WT, int ldt, int dst_row0, int k0,
                                               LAS float* scr, int lane) {
#pragma unroll 8
    for (int i = 0; i < 32; ++i) { const int kk = 2 * i + (lane >> 5); float v = W[(size_t)(k0 + kk) * ldw + src_col0 + (lane & 31)]; if (gain) v *= gain[k0 + kk]; scr[kk * 33 + (lane & 31)] = v; }
    asm volatile("s_waitcnt lgkmcnt(0)" ::: "memory");
    const int c = lane & 7;
#pragma unroll
    for (int j = 0; j < 4; ++j) { const int n = (lane >> 3) + 8 * j; const LAS float* s = scr + (8 * c) * 33 + n;
        u32x4 o; o.x = pkbf(s[0 * 33], s[1 * 33]); o.y = pkbf(s[2 * 33], s[3 * 33]); o.z = pkbf(s[4 * 33], s[5 * 33]); o.w = pkbf(s[6 * 33], s[7 * 33]);
        *(u32x4*)(WT + (size_t)(dst_row0 + n) * ldt + k0 + 8 * c) = o; }
    asm volatile("s_waitcnt lgkmcnt(0)" ::: "memory");
}

struct Params {
    const float* in[20];
    float* out;
    unsigned char* ws;
};

__device__ __forceinline__ void p0_prologue(const Params& p, ldsp_t lds, int vcu, int G) {
    const int tid = threadIdx.x, lane = tid & 63, wave = __builtin_amdgcn_readfirstlane(tid >> 6);
    unsigned char* ws = p.ws;
    const float* x = p.in[0]; const float* mem = p.in[1]; const float* g_mix = p.in[2]; const float* w_in = p.in[3]; const float* b_forget = p.in[4];
    const float* w_out = p.in[8]; const float* g_xattn = p.in[9]; const float* w_xq = p.in[10]; const float* w_xkv = p.in[11]; const float* g_mem = p.in[12];
    const float* w_xo = p.in[15]; const float* g_ffn = p.in[16]; const float* w_gate = p.in[17]; const float* w_up = p.in[18]; const float* w_down = p.in[19];
    LAS float* scr = (LAS float*)(lds + wave * 8448);
    LAS float* wfT = (LAS float*)(lds + 98304);
    for (int i = tid; i < 8192; i += NTHR) { const int k = i >> 3, c = i & 7; wfT[c * 1024 + k] = w_in[(size_t)k * INW + 3584 + c] * g_mix[k]; }
    const int gw = vcu * NWAVES + wave, NGW = G * NWAVES;
    constexpr int I_IN = 16 * 112, I_OUT = 16 * 32, I_XQ = 16 * 32, I_XKV = 16 * 64, I_XO = 16 * 32, I_GU = 16 * 176, I_D = 44 * 32;
    constexpr int NITEMS = I_IN + I_OUT + I_XQ + I_XKV + I_XO + I_GU + I_D;
    for (int it = gw; it < NITEMS; it += NGW) {
        int r = it;
        if (r < I_IN) { const int kb = r / 112, nb = r % 112, p0 = 32 * nb, pt = p0 >> 8, pp = p0 & 255;
            const int lcol = 256 * pt + 64 * ((pp >> 5) & 3) + 32 * (pp >> 7);
            transpose_item(w_in, INW, lcol, nullptr, (bf16_t*)(ws + WS_WIN), 1024, p0, 64 * kb, scr, lane); continue; } r -= I_IN;
        if (r < I_OUT) { const int kb = r / 32, nb = r % 32; transpose_item(w_out, 1024, 32 * nb, nullptr, (bf16_t*)(ws + WS_WOUT), 1024, 32 * nb, 64 * kb, scr, lane); continue; } r -= I_OUT;
        if (r < I_XQ) { const int kb = r / 32, nb = r % 32; transpose_item(w_xq, 1024, 32 * nb, g_xattn, (bf16_t*)(ws + WS_WXQ), 1024, 32 * nb, 64 * kb, scr, lane); continue; } r -= I_XQ;
        if (r < I_XKV) { const int kb = r / 64, nb = r % 64; transpose_item(w_xkv, 2048, 32 * nb, nullptr, (bf16_t*)(ws + WS_WXKV), 1024, 32 * nb, 64 * kb, scr, lane); continue; } r -= I_XKV;
        if (r < I_XO) { const int kb = r / 32, nb = r % 32; transpose_item(w_xo, 1024, 32 * nb, nullptr, (bf16_t*)(ws + WS_WXO), 1024, 32 * nb, 64 * kb, scr, lane); continue; } r -= I_XO;
        if (r < I_GU) { const int kb = r / 176, nb = r % 176, p0 = 32 * nb, pt = p0 >> 8, pp = p0 & 255;
            const float* W = (pp >> 7) ? w_up : w_gate; const int lcol = 128 * pt + (pp & 127);
            transpose_item(W, DFF, lcol, g_ffn, (bf16_t*)(ws + WS_WGU), 1024, p0, 64 * kb, scr, lane); continue; } r -= I_GU;
        { const int kb = r / 32, nb = r % 32; transpose_item(w_down, 1024, 32 * nb, nullptr, (bf16_t*)(ws + WS_WD), DFF, 32 * nb, 64 * kb, scr, lane); }
    }
    __syncthreads();
    {
        f32x4 gm[4];
#pragma unroll
        for (int j = 0; j < 4; ++j) gm[j] = ((const f32x4*)g_mix)[lane + 64 * j];
        bf16_t* hn = (bf16_t*)(ws + WS_HN); float* logf = (float*)(ws + WS_LOGF);
        for (int m = gw; m < MROWS; m += NGW) {
            const f32x4* xr = (const f32x4*)(x + (size_t)m * DM) + lane;
            f32x4 v[4]; float s = 0.f;
#pragma unroll
            for (int j = 0; j < 4; ++j) { v[j] = xr[64 * j]; s += (v[j][0] * v[j][0] + v[j][1] * v[j][1]) + (v[j][2] * v[j][2] + v[j][3] * v[j][3]); }
            const float rs = rsqrtf(wave_sum(s) * (1.0f / 1024.0f) + EPS);
            float ff[8];
#pragma unroll
            for (int c = 0; c < 8; ++c) { float a = 0.f;
#pragma unroll
                for (int j = 0; j < 4; ++j) { const f32x4 w = *(const LAS f32x4*)(wfT + c * 1024 + 256 * j + 4 * lane); a += (v[j][0] * w[0] + v[j][1] * w[1]) + (v[j][2] * w[2] + v[j][3] * w[3]); }
                ff[c] = wave_sum(a) * rs; }
            unsigned long long* o8 = (unsigned long long*)(hn + (size_t)m * DM) + lane;
#pragma unroll
            for (int j = 0; j < 4; ++j) { const f32x4 y = v[j] * gm[j] * rs; o8[64 * j] = (unsigned long long)pkbf(y[0], y[1]) | ((unsigned long long)pkbf(y[2], y[3]) << 32); }
            if (lane < 8) { float z = 0.f;
#pragma unroll
                for (int c = 0; c < 8; ++c) if (lane == c) z = ff[c];
                z += b_forget[lane];
                logf[(size_t)m * 8 + lane] = fminf(z, 0.f) - log1pf(__expf(-fabsf(z))); }
        }
#pragma unroll
        for (int j = 0; j < 4; ++j) gm[j] = ((const f32x4*)g_mem)[lane + 64 * j];
        bf16_t* memn = (bf16_t*)(ws + WS_MEMN);
        for (int m = gw; m < MEMROWS; m += NGW) {
            const f32x4* xr = (const f32x4*)(mem + (size_t)m * DM) + lane;
            f32x4 v[4]; float s = 0.f;
#pragma unroll
            for (int j = 0; j < 4; ++j) { v[j] = xr[64 * j]; s += (v[j][0] * v[j][0] + v[j][1] * v[j][1]) + (v[j][2] * v[j][2] + v[j][3] * v[j][3]); }
            const float rs = rsqrtf(wave_sum(s) * (1.0f / 1024.0f) + EPS);
            unsigned long long* o8 = (unsigned long long*)(memn + (size_t)m * DM) + lane;
#pragma unroll
            for (int j = 0; j < 4; ++j) { const f32x4 y = v[j] * gm[j] * rs; o8[64 * j] = (unsigned long long)pkbf(y[0], y[1]) | ((unsigned long long)pkbf(y[2], y[3]) << 32); }
        }
    }
    {
        float* cs = (float*)(ws + WS_COS); float* sn = (float*)(ws + WS_SIN);
        for (int e = vcu * NTHR + tid; e < SEQ * 32; e += G * NTHR) {
            const int t = e >> 5, i = e & 31;
            double invf = 1.0; for (int k = 0; k < i; ++k) invf *= 0.74989420933245582730;
            const double rev = (double)t * invf * 0.15915494309189533577;
            const float fr = (float)(rev - __builtin_rint(rev));
            cs[e] = __builtin_amdgcn_cosf(fr); sn[e] = __builtin_amdgcn_sinf(fr);
        }
    }
}

__device__ __forceinline__ void fox_cumsum(const Params& p, ldsp_t lds, int bh) {
    const int tid = threadIdx.x; const int b = bh >> 3, h = bh & 7;
    const float* logf = (const float*)(p.ws + WS_LOGF) + ((size_t)b * SEQ) * 8 + h; float* Fc = (float*)(p.ws + WS_FC) + (size_t)bh * SEQ;
    LAS double* part = (LAS double*)lds;
    double loc[8]; double run = 0.0;
#pragma unroll
    for (int i = 0; i < 8; ++i) { run += (double)logf[(size_t)(tid * 8 + i) * 8]; loc[i] = run; }
    part[tid] = run; __syncthreads();
    for (int o = 1; o < NTHR; o <<= 1) { double v = (tid >= o) ? part[tid - o] : 0.0; __syncthreads(); part[tid] += v; __syncthreads(); }
    const double base = (tid > 0) ? part[tid - 1] : 0.0;
#pragma unroll
    for (int i = 0; i < 8; ++i) Fc[tid * 8 + i] = (float)((base + loc[i]) * 1.4426950408889634);
    __syncthreads();
}

__device__ __forceinline__ void ret_kv_unit(const Params& p, ldsp_t lds, int u) {
    const int tid = threadIdx.x, lane = tid & 63, wid = __builtin_amdgcn_readfirstlane(tid >> 6), r32 = lane & 31, hi = lane >> 5;
    const int bh = u >> 5, cp = u & 31, b = bh >> 3, h = bh & 7;
    const bf16_t* P = (const bf16_t*)(p.ws + WS_P); float* kvT = (float*)(p.ws + WS_KVT);
    const float lg = log2f(1.0f - exp2f(-5.0f - (float)h));
    {
        const int ch = tid >> 8, t = tid & 255, row = t >> 2, c0 = (t & 3) * 16;
        const size_t grow = (size_t)b * SEQ + (size_t)(2 * cp + ch) * 64 + row;
        const bf16_t* kp = P + grow * PP + C_RK + h * 64 + c0; const bf16_t* vp = P + grow * PP + C_RV + h * 64 + c0;
        u32x4 k0 = *(const u32x4*)kp, k1 = *(const u32x4*)(kp + 8), v0 = *(const u32x4*)vp, v1 = *(const u32x4*)(vp + 8);
        const float dec = exp2f(lg * (float)(63 - row));
        u32x4 d0, d1;
        d0.x = pkbf(bflo(k0.x) * dec, bfhi(k0.x) * dec); d0.y = pkbf(bflo(k0.y) * dec, bfhi(k0.y) * dec); d0.z = pkbf(bflo(k0.z) * dec, bfhi(k0.z) * dec); d0.w = pkbf(bflo(k0.w) * dec, bfhi(k0.w) * dec);
        d1.x = pkbf(bflo(k1.x) * dec, bfhi(k1.x) * dec); d1.y = pkbf(bflo(k1.y) * dec, bfhi(k1.y) * dec); d1.z = pkbf(bflo(k1.z) * dec, bfhi(k1.z) * dec); d1.w = pkbf(bflo(k1.w) * dec, bfhi(k1.w) * dec);
        ldsp_t kl = lds + ch * 18432 + row * 144 + c0 * 2; ldsp_t vl = kl + 9216;
        *(LAS u32x4*)kl = d0; *(LAS u32x4*)(kl + 16) = d1; *(LAS u32x4*)vl = v0; *(LAS u32x4*)(vl + 16) = v1;
    }
    __syncthreads();
    {
        const int ch = wid >> 2, eb = (wid >> 1) & 1, db = wid & 1;
        ldsp_t kl = lds + ch * 18432, vl = kl + 9216;
        const int q = (lane & 15) >> 2, pq = lane & 3, g1 = (lane >> 4) & 1;
        f32x16 acc = {};
#pragma unroll
        for (int s = 0; s < 4; ++s) {
            const int r0 = 16 * s + 8 * hi + q;
            const bf16x8 a = cat8(tr_rd(vl + r0 * 144 + (32 * eb + 16 * g1 + 4 * pq) * 2), tr_rd(vl + (r0 + 4) * 144 + (32 * eb + 16 * g1 + 4 * pq) * 2));
            const bf16x8 bb = cat8(tr_rd(kl + r0 * 144 + (32 * db + 16 * g1 + 4 * pq) * 2), tr_rd(kl + (r0 + 4) * 144 + (32 * db + 16 * g1 + 4 * pq) * 2));
            acc = MFMA32(a, bb, acc);
        }
        float* op = kvT + ((size_t)bh * 64 + 2 * cp + ch) * 4096;
#pragma unroll
        for (int r = 0; r < 16; ++r) op[(32 * eb + crow(r, hi)) * 64 + 32 * db + r32] = acc[r];
    }
    __syncthreads();
}

__device__ __forceinline__ void ret_scan(const Params& p, int vcu, int G) {
    const float* kvT = (const float*)(p.ws + WS_KVT); bf16_t* St = (bf16_t*)(p.ws + WS_ST);
    for (int g = vcu * NTHR + (int)threadIdx.x; g < 32 * 4096; g += G * NTHR) {
        const int bh = g >> 12, idx = g & 4095, h = bh & 7;
        const float cd = exp2f(64.0f * log2f(1.0f - exp2f(-5.0f - (float)h)));
        const float* src = kvT + (size_t)bh * 64 * 4096 + idx; bf16_t* dst = St + (size_t)bh * 64 * 4096 + idx;
        float s = 0.f;
        for (int c0 = 0; c0 < 64; c0 += 8) {
            float v[8];
#pragma unroll
            for (int i = 0; i < 8; ++i) v[i] = src[(size_t)(c0 + i) * 4096];
#pragma unroll
            for (int i = 0; i < 8; ++i) { dst[(size_t)(c0 + i) * 4096] = (bf16_t)(pkbf(s, 0.f) & 0xffffu); s = s * cd + v[i]; }
        }
    }
}

__device__ __forceinline__ void ret_out_unit(const Params& p, ldsp_t lds, int u) {
    const int tid = threadIdx.x, lane = tid & 63, wid = __builtin_amdgcn_readfirstlane(tid >> 6), r32 = lane & 31, hi = lane >> 5;
    const int bh = u >> 4, cgp = u & 15, b = bh >> 3, h = bh & 7;
    const bf16_t* P = (const bf16_t*)(p.ws + WS_P); const bf16_t* St = (const bf16_t*)(p.ws + WS_ST); bf16_t* mix = (bf16_t*)(p.ws + WS_HN);
    const float* g_ret = p.in[5] + h * 64;
    const float lg = log2f(1.0f - exp2f(-5.0f - (float)h));
    {
        const int ch = tid >> 7, t = tid & 127, row = t >> 1, c0 = (t & 1) * 32;
        const bf16_t* vp = P + ((size_t)b * SEQ + (size_t)(4 * cgp + ch) * 64 + row) * PP + C_RV + h * 64 + c0;
        ldsp_t vl = lds + ch * 9216 + row * 144 + c0 * 2;
#pragma unroll
        for (int i = 0; i < 4; ++i) *(LAS u32x4*)(vl + 16 * i) = *(const u32x4*)(vp + 8 * i);
    }
    __syncthreads();
    {
        const int ch = wid >> 1, ih = wid & 1, c = 4 * cgp + ch;
        const size_t crow0 = (size_t)b * SEQ + (size_t)c * 64;
        const int i_tok = 32 * ih + r32; const size_t row_i = crow0 + i_tok;
        bf16x8 qf[4];
#pragma unroll
        for (int s = 0; s < 4; ++s) qf[s] = *(const bf16x8*)(P + row_i * PP + C_RQ + h * 64 + 16 * s + 8 * hi);
        f32x16 st0 = {}, st1 = {};
#pragma unroll
        for (int s = 0; s < 4; ++s) {
            const bf16x8 k0 = *(const bf16x8*)(P + (crow0 + r32) * PP + C_RK + h * 64 + 16 * s + 8 * hi);
            const bf16x8 k1 = *(const bf16x8*)(P + (crow0 + 32 + r32) * PP + C_RK + h * 64 + 16 * s + 8 * hi);
            st0 = MFMA32(k0, qf[s], st0); st1 = MFMA32(k1, qf[s], st1);
        }
#pragma unroll
        for (int r = 0; r < 16; ++r) { const int j0 = crow(r, hi), j1 = 32 + j0;
            st0[r] *= 0.125f * exp2f(lg * fabsf((float)(i_tok - j0))); st1[r] *= 0.125f * exp2f(lg * fabsf((float)(i_tok - j1))); }
        bf16x8 pf[4]; pf[0] = pack8(st0, 0); pf[1] = pack8(st0, 1); pf[2] = pack8(st1, 0); pf[3] = pack8(st1, 1);
        ldsp_t vl = lds + ch * 9216;
        const int q = (lane & 15) >> 2, pq = lane & 3, g1 = (lane >> 4) & 1;
        f32x16 o0 = {}, o1 = {}, t0 = {}, t1 = {};
        const bf16_t* Sp = St + ((size_t)bh * 64 + c) * 4096;
#pragma unroll
        for (int s = 0; s < 4; ++s) {
            const int r0 = 16 * s + 4 * hi + q;
            const bf16x8 a0 = cat8(tr_rd(vl + r0 * 144 + (16 * g1 + 4 * pq) * 2), tr_rd(vl + (r0 + 8) * 144 + (16 * g1 + 4 * pq) * 2));
            const bf16x8 a1 = cat8(tr_rd(vl + r0 * 144 + (32 + 16 * g1 + 4 * pq) * 2), tr_rd(vl + (r0 + 8) * 144 + (32 + 16 * g1 + 4 * pq) * 2));
            o0 = MFMA32(a0, pf[s], o0); o1 = MFMA32(a1, pf[s], o1);
            const bf16x8 s0 = *(const bf16x8*)(Sp + (size_t)r32 * 64 + 16 * s + 8 * hi);
            const bf16x8 s1 = *(const bf16x8*)(Sp + (size_t)(32 + r32) * 64 + 16 * s + 8 * hi);
            t0 = MFMA32(s0, qf[s], t0); t1 = MFMA32(s1, qf[s], t1);
        }
        const float qd = 0.125f * exp2f(lg * (float)(i_tok + 1));
        float sum = 0.f;
#pragma unroll
        for (int r = 0; r < 16; ++r) { o0[r] += qd * t0[r]; o1[r] += qd * t1[r]; sum += o0[r] + o1[r]; }
        sum += __shfl_xor(sum, 32); const float mu = sum * (1.0f / 64.0f);
        float var = 0.f;
#pragma unroll
        for (int r = 0; r < 16; ++r) { o0[r] -= mu; o1[r] -= mu; var += o0[r] * o0[r] + o1[r] * o1[r]; }
        var += __shfl_xor(var, 32); const float rstd = rsqrtf(var * (1.0f / 64.0f) + EPS);
        const bf16_t* gp = P + row_i * PP + C_RG + h * 64; bf16_t* mp = mix + row_i * DM + h * 64;
#pragma unroll
        for (int eb = 0; eb < 2; ++eb)
#pragma unroll
            for (int g = 0; g < 4; ++g) {
                const int e0 = 32 * eb + 8 * g + 4 * hi;
                const u32x2 gw = *(const u32x2*)(gp + e0); const f32x4 gr = *(const f32x4*)(g_ret + e0);
                const float gt[4] = {bflo(gw.x), bfhi(gw.x), bflo(gw.y), bfhi(gw.y)}; float y[4];
#pragma unroll
                for (int e = 0; e < 4; ++e) { const float v = (eb ? o1[4 * g + e] : o0[4 * g + e]) * rstd * gr[e]; const float z = gt[e];
                    y[e] = v * z * __builtin_amdgcn_rcpf(1.0f + __builtin_amdgcn_exp2f(-z * LOG2E)); }
                u32x2 w; w.x = pkbf(y[0], y[1]); w.y = pkbf(y[2], y[3]); *(u32x2*)(mp + e0) = w;
            }
    }
    __syncthreads();
}

__device__ __forceinline__ void fox_unit(const Params& p, ldsp_t lds, int bh, int qb) {
    const int tid = threadIdx.x, lane = tid & 63, wid = __builtin_amdgcn_readfirstlane(tid >> 6), r32 = lane & 31, hi = lane >> 5;
    const int b = bh >> 3, h = bh & 7; const size_t rowbase = (size_t)b * SEQ; const int t0 = qb * 256;
    const bf16_t* P = (const bf16_t*)(p.ws + WS_P); bf16_t* mix = (bf16_t*)(p.ws + WS_HN);
    const bf16_t* Kg = P + rowbase * PP + C_FK + h * 64; const bf16_t* Vg = P + rowbase * PP + C_FV + h * 64;
    const float* Fg = (const float*)(p.ws + WS_FC) + (size_t)bh * SEQ;
    const float fref = Fg[t0];
    const size_t qrow = rowbase + t0 + wid * 32 + r32;
    bf16x8 qr[4];
#pragma unroll
    for (int s = 0; s < 4; ++s) qr[s] = *(const bf16x8*)(P + qrow * PP + C_FQ + h * 64 + 16 * s + 8 * hi);
    const int srow = tid >> 3, sch = tid & 7;
    const int NT = 4 * qb + 4;
    u32x4 kreg = *(const u32x4*)(Kg + (size_t)srow * PP + sch * 8), vreg = *(const u32x4*)(Vg + (size_t)srow * PP + sch * 8);
    float freg = (tid < 64) ? (fref - Fg[tid]) : 0.f;
    *(LAS u32x4*)(lds + srow * 144 + sch * 16) = kreg; *(LAS u32x4*)(lds + 18432 + srow * 144 + sch * 16) = vreg;
    if (tid < 64) *(LAS float*)(lds + 36864 + tid * 4) = freg;
    __syncthreads();
    f32x16 o0 = {}, o1 = {}; float mrun = -INFINITY, lrun = 0.f;
    const int qrel = wid * 32 + r32;
    const int q = (lane & 15) >> 2, pq = lane & 3, g1 = (lane >> 4) & 1;
    for (int tk = 0; tk < NT; ++tk) {
        const int buf = tk & 1; const bool more = (tk + 1 < NT);
        if (more) { const size_t r = (size_t)(tk + 1) * 64 + srow; kreg = *(const u32x4*)(Kg + r * PP + sch * 8); vreg = *(const u32x4*)(Vg + r * PP + sch * 8);
            if (tid < 64) freg = fref - Fg[(tk + 1) * 64 + tid]; }
        const int jb = tk - (NT - 4);
        if (!(jb >= 0 && 64 * jb > wid * 32 + 31)) {
            ldsp_t kl = lds + buf * 9216, vl = lds + 18432 + buf * 9216; const LAS float* nb = (const LAS float*)(lds + 36864 + buf * 256);
            f32x16 p0 = {}, p1 = {};
#pragma unroll
            for (int s = 0; s < 4; ++s) {
                const bf16x8 k0 = *(const LAS bf16x8*)(kl + r32 * 144 + (16 * s + 8 * hi) * 2);
                const bf16x8 k1 = *(const LAS bf16x8*)(kl + (32 + r32) * 144 + (16 * s + 8 * hi) * 2);
                p0 = MFMA32(k0, qr[s], p0); p1 = MFMA32(k1, qr[s], p1);
            }
#pragma unroll
            for (int g = 0; g < 4; ++g) { const f32x4 n0 = *(const LAS f32x4*)(nb + 8 * g + 4 * hi), n1 = *(const LAS f32x4*)(nb + 32 + 8 * g + 4 * hi);
#pragma unroll
                for (int e = 0; e < 4; ++e) { p0[4 * g + e] += n0[e]; p1[4 * g + e] += n1[e]; } }
            if (jb >= 0) {
#pragma unroll
                for (int r = 0; r < 16; ++r) { const int kv = 64 * jb + crow(r, hi); if (kv > qrel) p0[r] = -INFINITY; if (kv + 32 > qrel) p1[r] = -INFINITY; }
            }
            float mx = fmaxf(p0[0], p1[0]);
#pragma unroll
            for (int r = 1; r < 16; ++r) mx = fmaxf(mx, fmaxf(p0[r], p1[r]));
            mx = fmaxf(mx, __shfl_xor(mx, 32));
            const float mnew = fmaxf(mrun, mx); const float sc = __builtin_amdgcn_exp2f(mrun - mnew); mrun = mnew;
            float rsum = 0.f;
#pragma unroll
            for (int r = 0; r < 16; ++r) { p0[r] = __builtin_amdgcn_exp2f(p0[r] - mnew); p1[r] = __builtin_amdgcn_exp2f(p1[r] - mnew); rsum += p0[r] + p1[r]; }
            lrun = lrun * sc + rsum;
#pragma unroll
            for (int r = 0; r < 16; ++r) { o0[r] *= sc; o1[r] *= sc; }
            bf16x8 pf[4]; pf[0] = pack8(p0, 0); pf[1] = pack8(p0, 1); pf[2] = pack8(p1, 0); pf[3] = pack8(p1, 1);
#pragma unroll
            for (int s = 0; s < 4; ++s) {
                const int r0 = 16 * s + 4 * hi + q;
                const bf16x8 a0 = cat8(tr_rd(vl + r0 * 144 + (16 * g1 + 4 * pq) * 2), tr_rd(vl + (r0 + 8) * 144 + (16 * g1 + 4 * pq) * 2));
                const bf16x8 a1 = cat8(tr_rd(vl + r0 * 144 + (32 + 16 * g1 + 4 * pq) * 2), tr_rd(vl + (r0 + 8) * 144 + (32 + 16 * g1 + 4 * pq) * 2));
                o0 = MFMA32(a0, pf[s], o0); o1 = MFMA32(a1, pf[s], o1);
            }
        }
        if (more) { const int nbuf = buf ^ 1;
            *(LAS u32x4*)(lds + nbuf * 9216 + srow * 144 + sch * 16) = kreg; *(LAS u32x4*)(lds + 18432 + nbuf * 9216 + srow * 144 + sch * 16) = vreg;
            if (tid < 64) *(LAS float*)(lds + 36864 + nbuf * 256 + tid * 4) = freg; }
        __syncthreads();
    }
    lrun += __shfl_xor(lrun, 32);
    const float inv = 1.0f / lrun;
    bf16_t* mp = mix + qrow * DM + 512 + h * 64;
#pragma unroll
    for (int g = 0; g < 4; ++g) {
        u32x2 w0, w1; w0.x = pkbf(o0[4 * g] * inv, o0[4 * g + 1] * inv); w0.y = pkbf(o0[4 * g + 2] * inv, o0[4 * g + 3] * inv);
        w1.x = pkbf(o1[4 * g] * inv, o1[4 * g + 1] * inv); w1.y = pkbf(o1[4 * g + 2] * inv, o1[4 * g + 3] * inv);
        *(u32x2*)(mp + 8 * g + 4 * hi) = w0; *(u32x2*)(mp + 32 + 8 * g + 4 * hi) = w1;
    }
}

__device__ __forceinline__ void xattn_unit(const Params& p, ldsp_t lds, int u) {
    const int tid = threadIdx.x, lane = tid & 63, wid = __builtin_amdgcn_readfirstlane(tid >> 6), r32 = lane & 31, hi = lane >> 5;
    const int b = u >> 6, qblk = (u & 63) >> 2, hd = u & 3;
    const bf16_t* qx = (const bf16_t*)(p.ws + WS_QX); const bf16_t* KV = (const bf16_t*)(p.ws + WS_KVM); bf16_t* ob = (bf16_t*)(p.ws + WS_O);
    const float* ss1 = (const float*)(p.ws + WS_SS1); const float* qss = (const float*)(p.ws + WS_QSS); const float* kss = (const float*)(p.ws + WS_KSS);
    const size_t R = (size_t)b * SEQ + qblk * 256 + wid * 32 + r32;
    float qscale;
    { const f32x4* sp = (const f32x4*)(ss1 + R * 16); const f32x4 a = sp[0], bq = sp[1], c = sp[2], d = sp[3];
      const float tot = ((a[0] + a[1]) + (a[2] + a[3])) + ((bq[0] + bq[1]) + (bq[2] + bq[3])) + ((c[0] + c[1]) + (c[2] + c[3])) + ((d[0] + d[1]) + (d[2] + d[3]));
      const float r1 = rsqrtf(tot * (1.0f / 1024.0f) + EPS);
      const f32x4 qv = *(const f32x4*)(qss + R * 16 + hd * 4); const float qs = (qv[0] + qv[1]) + (qv[2] + qv[3]);
      qscale = r1 * rsqrtf(r1 * r1 * qs * (1.0f / 256.0f) + EPS) * (0.0625f * LOG2E); }
    const bf16_t* qp = qx + R * DM + hd * 256 + 8 * hi;
    f32x16 o[8];
#pragma unroll
    for (int i = 0; i < 8; ++i) o[i] = (f32x16){};
    float mrun = -INFINITY, lrun = 0.f;
    const int q = (lane & 15) >> 2, pq = lane & 3, g1 = (lane >> 4) & 1;
    const int srow = tid >> 3, spart = tid & 7;
    for (int kt = 0; kt < 4; ++kt) {
        { const size_t mrow = (size_t)b * NMEM + kt * 64 + srow;
          const bf16_t* kp = KV + mrow * 2048 + hd * 256 + spart * 32; const bf16_t* vp = kp + 1024;
          ldsp_t kl = lds + srow * 528 + spart * 64; ldsp_t vl = kl + 33792;
#pragma unroll
          for (int i = 0; i < 4; ++i) { *(LAS u32x4*)(kl + 16 * i) = *(const u32x4*)(kp + 8 * i); *(LAS u32x4*)(vl + 16 * i) = *(const u32x4*)(vp + 8 * i); }
          if (tid < 64) { const size_t mr = (size_t)b * NMEM + kt * 64 + tid; const f32x4 kv4 = *(const f32x4*)(kss + mr * 16 + hd * 4);
              *(LAS float*)(lds + 67584 + tid * 4) = rsqrtf(((kv4[0] + kv4[1]) + (kv4[2] + kv4[3])) * (1.0f / 256.0f) + EPS); } }
        __syncthreads();
        {
            ldsp_t kl = lds, vl = lds + 33792; const LAS float* ksc = (const LAS float*)(lds + 67584);
            f32x16 p0 = {}, p1 = {};
#pragma unroll 4
            for (int s = 0; s < 16; ++s) {
                const bf16x8 qf = *(const bf16x8*)(qp + 16 * s);
                const bf16x8 k0 = *(const LAS bf16x8*)(kl + r32 * 528 + (16 * s + 8 * hi) * 2);
                const bf16x8 k1 = *(const LAS bf16x8*)(kl + (32 + r32) * 528 + (16 * s + 8 * hi) * 2);
                p0 = MFMA32(k0, qf, p0); p1 = MFMA32(k1, qf, p1);
            }
#pragma unroll
            for (int g = 0; g < 4; ++g) { const f32x4 n0 = *(const LAS f32x4*)(ksc + 8 * g + 4 * hi), n1 = *(const LAS f32x4*)(ksc + 32 + 8 * g + 4 * hi);
#pragma unroll
                for (int e = 0; e < 4; ++e) { p0[4 * g + e] *= n0[e] * qscale; p1[4 * g + e] *= n1[e] * qscale; } }
            float mx = fmaxf(p0[0], p1[0]);
#pragma unroll
            for (int r = 1; r < 16; ++r) mx = fmaxf(mx, fmaxf(p0[r], p1[r]));
            mx = fmaxf(mx, __shfl_xor(mx, 32));
            const float mnew = fmaxf(mrun, mx); const float sc = __builtin_amdgcn_exp2f(mrun - mnew); mrun = mnew;
            float rsum = 0.f;
#pragma unroll
            for (int r = 0; r < 16; ++r) { p0[r] = __builtin_amdgcn_exp2f(p0[r] - mnew); p1[r] = __builtin_amdgcn_exp2f(p1[r] - mnew); rsum += p0[r] + p1[r]; }
            lrun = lrun * sc + rsum;
#pragma unroll
            for (int i = 0; i < 8; ++i)
#pragma unroll
                for (int r = 0; r < 16; ++r) o[i][r] *= sc;
            bf16x8 pf[4]; pf[0] = pack8(p0, 0); pf[1] = pack8(p0, 1); pf[2] = pack8(p1, 0); pf[3] = pack8(p1, 1);
#pragma unroll
            for (int s = 0; s < 4; ++s) {
                const int r0 = 16 * s + 4 * hi + q;
#pragma unroll
                for (int blk = 0; blk < 8; ++blk) {
                    const bf16x8 a = cat8(tr_rd(vl + r0 * 528 + (32 * blk + 16 * g1 + 4 * pq) * 2), tr_rd(vl + (r0 + 8) * 528 + (32 * blk + 16 * g1 + 4 * pq) * 2));
                    o[blk] = MFMA32(a, pf[s], o[blk]);
                }
            }
        }
        __syncthreads();
    }
    lrun += __shfl_xor(lrun, 32);
    const float inv = 1.0f / lrun;
    bf16_t* op = ob + R * DM + hd * 256;
#pragma unroll
    for (int blk = 0; blk < 8; ++blk)
#pragma unroll
        for (int g = 0; g < 4; ++g) {
            u32x2 w; w.x = pkbf(o[blk][4 * g] * inv, o[blk][4 * g + 1] * inv); w.y = pkbf(o[blk][4 * g + 2] * inv, o[blk][4 * g + 3] * inv);
            *(u32x2*)(op + 32 * blk + 8 * g + 4 * hi) = w;
        }
}

#ifndef PH_LO
#define PH_LO 0
#endif
__global__ void __launch_bounds__(NTHR, 2) hymba_fwd(Params p, int ph_lo, int ph_hi, int coop) {
    extern __shared__ __attribute__((aligned(16))) unsigned char lds_raw[];
    ldsp_t lds = (ldsp_t)lds_raw;
    const int G = gridDim.x, bx = blockIdx.x;
    const int vcu = (G % 8 == 0) ? (bx % 8) * (G / 8) + bx / 8 : bx;
    unsigned char* ws = p.ws;
    bf16_t* HN = (bf16_t*)(ws + WS_HN); bf16_t* PB = (bf16_t*)(ws + WS_P);
#ifndef PHMASK
#define PHMASK 0x7ff
#endif
#define IN(k) (((PHMASK >> (k)) & 1) && ph_lo <= (k) && (k) < ph_hi)
#define SEAM(k) do { if (coop && IN(k) && IN((k) + 1)) cg::this_grid().sync(); } while (0)
    if (IN(0)) { p0_prologue(p, lds, vcu, G); __syncthreads(); }
    SEAM(0);
    if (IN(1)) {
        { pg8::Gemm g{HN, (const bf16_t*)(ws + WS_WIN), MROWS, 3584, 1024}; pg8::StaticOrder S; S.init(MROWS, 3584, G, bx);
          pg8::EpiProj E{PB, (const float*)(ws + WS_COS), (const float*)(ws + WS_SIN), p.in[6], p.in[7]};
          pg8::gemm_phase<pg8::EpiProj, pg8::StaticOrder, true, true>(lds, g, S, E); }
        { pg8::Gemm g{(const bf16_t*)(ws + WS_MEMN), (const bf16_t*)(ws + WS_WXKV), MEMROWS, 2048, 1024}; pg8::StaticOrder S; S.init(MEMROWS, 2048, G, (bx + G / 2) % G);
          pg8::EpiKV E{(bf16_t*)(ws + WS_KVM), (float*)(ws + WS_KSS), p.in[13], p.in[14]};
          pg8::gemm_phase<pg8::EpiKV, pg8::StaticOrder, true, true>(lds, g, S, E); }
        __syncthreads();
        for (int bh = bx - 160; bh >= 0 && bh < 32; bh += 1000) fox_cumsum(p, lds, bh);
        if (G < 192) { for (int bh = bx; bh < 32; bh += G) fox_cumsum(p, lds, bh); }
    }
    SEAM(1);
    if (IN(2)) {
        for (int u = vcu; u < 1024; u += G) ret_kv_unit(p, lds, u);
        for (int c = vcu; c < 256; c += G) { const int bh = c >> 3, s = c & 7; fox_unit(p, lds, bh, 15 - s); fox_unit(p, lds, bh, s); }
    }
    SEAM(2);
    if (IN(3)) ret_scan(p, vcu, G);
    SEAM(3);
    if (IN(4)) { for (int u = vcu; u < 512; u += G) ret_out_unit(p, lds, u); }
    SEAM(4);
    if (IN(5)) { pg8::Gemm g{HN, (const bf16_t*)(ws + WS_WOUT), MROWS, 1024, 1024}; pg8::StaticOrder S; S.init(MROWS, 1024, G, bx);
        pg8::EpiRes E{p.in[0], p.out, (bf16_t*)(ws + WS_H1B), (float*)(ws + WS_SS1)};
        pg8::gemm_phase<pg8::EpiRes, pg8::StaticOrder, true, true>(lds, g, S, E); }
    SEAM(5);
    if (IN(6)) { pg8::Gemm g{(const bf16_t*)(ws + WS_H1B), (const bf16_t*)(ws + WS_WXQ), MROWS, 1024, 1024}; pg8::StaticOrder S; S.init(MROWS, 1024, G, bx);
        pg8::EpiXq E{(bf16_t*)(ws + WS_QX), (float*)(ws + WS_QSS)};
        pg8::gemm_phase<pg8::EpiXq, pg8::StaticOrder, true, true>(lds, g, S, E); }
    SEAM(6);
    if (IN(7)) { __syncthreads(); for (int u = vcu; u < 256; u += G) xattn_unit(p, lds, u); }
    SEAM(7);
    if (IN(8)) { pg8::Gemm g{(const bf16_t*)(ws + WS_O), (const bf16_t*)(ws + WS_WXO), MROWS, 1024, 1024}; pg8::StaticOrder S; S.init(MROWS, 1024, G, bx);
        pg8::EpiRes E{p.out, p.out, (bf16_t*)(ws + WS_H1B), (float*)(ws + WS_SS2)};
        pg8::gemm_phase<pg8::EpiRes, pg8::StaticOrder, true, true>(lds, g, S, E); }
    SEAM(8);
    if (IN(9)) { pg8::Gemm g{(const bf16_t*)(ws + WS_H1B), (const bf16_t*)(ws + WS_WGU), MROWS, 5632, 1024}; pg8::StaticOrder S; S.init(MROWS, 5632, G, bx);
        pg8::EpiGU E{(bf16_t*)(ws + WS_ACT), (const float*)(ws + WS_SS2)};
        pg8::gemm_phase<pg8::EpiGU, pg8::StaticOrder, true, true>(lds, g, S, E); }
    SEAM(9);
    if (IN(10)) { pg8::Gemm g{(const bf16_t*)(ws + WS_ACT), (const bf16_t*)(ws + WS_WD), MROWS, 1024, DFF}; pg8::StaticOrder S; S.init(MROWS, 1024, G, bx);
        pg8::EpiRes E{p.out, p.out, nullptr, nullptr};
        pg8::gemm_phase<pg8::EpiRes, pg8::StaticOrder, true, true>(lds, g, S, E); }
#undef IN
#undef SEAM
}

#ifndef N_LAUNCH_MODE
#define N_LAUNCH_MODE 11
#endif
extern "C" void kernel_launch(void* const* d_in, const int* in_sizes, int n_in, void* d_out, int out_size, void* d_ws, size_t ws_size, hipStream_t stream) {
    static int grid = 0;
    if (grid == 0) {
        int dev = 0, cus = 0, per_cu = 0;
        hipGetDevice(&dev); hipDeviceGetAttribute(&cus, hipDeviceAttributeMultiprocessorCount, dev);
        if (hipFuncSetAttribute((const void*)hymba_fwd, hipFuncAttributeMaxDynamicSharedMemorySize, LDS_BYTES) != hipSuccess) { fprintf(stderr, "hipFuncSetAttribute failed\n"); }
        if (hipOccupancyMaxActiveBlocksPerMultiprocessor(&per_cu, (const void*)hymba_fwd, NTHR, LDS_BYTES) != hipSuccess || per_cu < 1) { fprintf(stderr, "occupancy query: %d\n", per_cu); per_cu = 1; }
        (void)hipGetLastError();
        grid = cus * (per_cu > 1 ? 1 : per_cu);
        if (n_in != 20 || ws_size < WS_END) { fprintf(stderr, "kernel_launch: unexpected n_in %d / ws %zu\n", n_in, ws_size); }
    }
    Params p{};
    for (int i = 0; i < 20; ++i) p.in[i] = (const float*)d_in[i];
    p.out = (float*)d_out; p.ws = (unsigned char*)d_ws;
    if (N_LAUNCH_MODE == 1) {
        int lo = 0, hi = 11, coop = 1;
        void* args[] = {&p, &lo, &hi, &coop};
        hipError_t e = hipLaunchCooperativeKernel((const void*)hymba_fwd, dim3(grid), dim3(NTHR), args, LDS_BYTES, stream);
        if (e != hipSuccess) fprintf(stderr, "cooperative launch failed: %s (grid %d)\n", hipGetErrorString(e), grid);
    } else {
        for (int ph = 0; ph < 11; ++ph) hipLaunchKernelGGL(hymba_fwd, dim3(grid), dim3(NTHR), LDS_BYTES, stream, p, ph, ph + 1, 0);
    }
}
```

```cpp
#include <hip/hip_runtime.h>
#include <hip/hip_cooperative_groups.h>
#include <cstdio>
#include <cstdint>
namespace cg = cooperative_groups;
namespace pg8 {
#define PG8_LAS __attribute__((address_space(3)))
typedef unsigned short bf16_t;
typedef short bf16x8 __attribute__((ext_vector_type(8)));
typedef float f32x4 __attribute__((ext_vector_type(4)));
typedef unsigned u32x4 __attribute__((ext_vector_type(4)));
constexpr int BM = 256, BK = 64, HALF = 128, HTB = HALF * BK * 2  , STAGE_BYTES = 8 * HTB, NXCD = 8, WGM = 8;

__host__ __device__ __forceinline__ int lds_byte(int r, int c) { const int st = (r >> 4) * 2 + (c >> 5), rr = r & 15, cc = c & 31, ob = rr * 64 + cc * 2; return st * 1024 + (ob ^ (((ob >> 9) & 1) << 5)); }
__host__ __device__ __forceinline__ void stage_rc(int b, int& R, int& C) { const int st = b / 1024, sb = b % 1024, swz = sb ^ (((sb >> 9) & 1) << 5); R = (st >> 1) * 16 + swz / 64; C = (st & 1) * 32 + (swz % 64) / 2; }
__host__ __device__ __forceinline__ int perm32(int rho) { const int n = rho >> 4, i = rho & 15; return 8 * (i >> 2) + 4 * n + (i & 3); }

struct Unit { int pm, pn; };
struct Gemm { const bf16_t* A; const bf16_t* Bt; int M, N, K; };

struct StaticOrder {
    int nM, nN, nwg, G, c;
    __host__ __device__ void init(int M, int N, int G_, int c_) { nM = M / BM; nN = N / BM; nwg = nM * nN; G = G_; c = c_; }
    __host__ __device__ bool next(int i, Unit& u) const {
        const long L = (long)i * G + c; if (L >= nwg) return false;
        int wgid = (int)L; { const int q = nwg / NXCD, r = nwg % NXCD, xcd = wgid % NXCD, off = wgid / NXCD; wgid = (xcd < r ? xcd * (q + 1) : r * (q + 1) + (xcd - r) * q) + off; }
        const int nig = WGM * nN, gid = wgid / nig, fm = gid * WGM, gsz = (nM - fm) < WGM ? (nM - fm) : WGM;
        u.pm = fm + ((wgid % nig) % gsz); u.pn = (wgid % nig) / gsz; return true;
    }
    __device__ __forceinline__ void a_ready(const Unit&) const {}
    __device__ __forceinline__ void done(const Unit&) const {}
};

__device__ __forceinline__ unsigned cvt_pk_bf16(float lo, float hi) { unsigned r; asm volatile("v_cvt_pk_bf16_f32 %0, %1, %2" : "=v"(r) : "v"(lo), "v"(hi)); return r; }
typedef float f32x2 __attribute__((ext_vector_type(2)));
__device__ __forceinline__ f32x2 gelu_pk(f32x2 v) {
    const f32x2 av = __builtin_elementwise_abs(v), d = av * 0.2316418882f + 1.0f;
    f32x2 t; t.x = __builtin_amdgcn_rcpf(d.x); t.y = __builtin_amdgcn_rcpf(d.y);
    f32x2 q = t * 0.5307027145f + (-0.7265760135f); q = q * t + 0.7107068705f; q = q * t + (-0.142248368f); q = q * t + 0.127414796f; q = q * t;
    const f32x2 s = (v * v) * (-0.72134752044f);
    f32x2 e; e.x = __builtin_amdgcn_exp2f(s.x); e.y = __builtin_amdgcn_exp2f(s.y);
    const f32x2 m = v * (q * e), r = v - m;
    f32x2 o; o.x = v.x < 0.f ? m.x : r.x; o.y = v.y < 0.f ? m.y : r.y; return o;
}

template <int ACT  > struct EpiBf16 {
    static constexpr bool PERM = true, AFTER_DRAIN = false; static_assert(ACT == 0 || ACT == 1, "EpiBf16: ACT is 0 (none) or 1 (gelu_pk)");
    bf16_t* O; int ldc; const float* bias; int split_cols; size_t split_stride; float scale0;
    __device__ __forceinline__ void operator()(const f32x4 (&acc)[2][2][4][2], const Unit& u, int wr, int wc, int fr, int fq) const {
        const int row0 = u.pm * BM + wr * 64 + fr; int colt = u.pn * BM; bf16_t* base = O;
        float sc = 1.f; if (split_cols) { const int t = colt / split_cols; base += (size_t)t * split_stride; colt -= t * split_cols; if (t == 0) sc = scale0; }
        const int col0 = colt + wc * 32 + 8 * fq, bcol0 = u.pn * BM + wc * 32 + 8 * fq;
        f32x4 bv[2][2];
#pragma unroll
        for (int bj = 0; bj < 2; ++bj)
#pragma unroll
            for (int n = 0; n < 2; ++n) bv[bj][n] = bias ? *(const f32x4*)(bias + bcol0 + bj * HALF + 4 * n) : (f32x4){0.f, 0.f, 0.f, 0.f};
#pragma unroll
        for (int ai = 0; ai < 2; ++ai)
#pragma unroll
            for (int m = 0; m < 4; ++m) { bf16_t* rowp = base + (size_t)(row0 + ai * HALF + m * 16) * ldc + col0;
#pragma unroll
                for (int bj = 0; bj < 2; ++bj) { f32x4 v0 = acc[ai][bj][m][0] + bv[bj][0], v1 = acc[ai][bj][m][1] + bv[bj][1];
                    if (ACT == 1) { f32x2 a = gelu_pk((f32x2){v0[0], v0[1]}), b = gelu_pk((f32x2){v0[2], v0[3]}), c = gelu_pk((f32x2){v1[0], v1[1]}), d = gelu_pk((f32x2){v1[2], v1[3]});
                        v0 = (f32x4){a.x, a.y, b.x, b.y}; v1 = (f32x4){c.x, c.y, d.x, d.y}; }
                    v0 = v0 * sc; v1 = v1 * sc; u32x4 w; w.x = cvt_pk_bf16(v0[0], v0[1]); w.y = cvt_pk_bf16(v0[2], v0[3]); w.z = cvt_pk_bf16(v1[0], v1[1]); w.w = cvt_pk_bf16(v1[2], v1[3]);
                    *(u32x4*)(rowp + bj * HALF) = w; } }
    }
};

struct PanelStats {
    unsigned* xbuf;
    unsigned* cnt;
    unsigned* tmo;
    int ntn; float eps;
    unsigned code;
    __device__ __forceinline__ bool run(const f32x4 (&v)[2][2][4][2], const Unit& u, int wr, int wc, int fr, int fq, PG8_LAS unsigned char* lds, int wid, int lane) const {
        typedef float f32x2v __attribute__((ext_vector_type(2)));
        PG8_LAS f32x2v* P = (PG8_LAS f32x2v*)lds;
        PG8_LAS f32x2v* S = (PG8_LAS f32x2v*)(lds + 8192);
        PG8_LAS unsigned* flag = (PG8_LAS unsigned*)(lds + 8192 + 2048);
#pragma unroll
        for (int ai = 0; ai < 2; ++ai)
#pragma unroll
            for (int m = 0; m < 4; ++m) {
                float s = 0.f;
#pragma unroll
                for (int bj = 0; bj < 2; ++bj)
#pragma unroll
                    for (int n = 0; n < 2; ++n) { const f32x4 x = v[ai][bj][m][n]; s += (x[0] + x[1]) + (x[2] + x[3]); }
                s += __shfl_xor(s, 16); s += __shfl_xor(s, 32);
                const float mw = s * (1.0f / 64.0f); float q = 0.f;
#pragma unroll
                for (int bj = 0; bj < 2; ++bj)
#pragma unroll
                    for (int n = 0; n < 2; ++n) { const f32x4 d = v[ai][bj][m][n] - mw; q += (d[0] * d[0] + d[1] * d[1]) + (d[2] * d[2] + d[3] * d[3]); }
                q += __shfl_xor(q, 16); q += __shfl_xor(q, 32);
                if (fq == 0) P[(ai * HALF + wr * 64 + m * 16 + fr) * 4 + wc] = (f32x2v){mw, q};
            }
        asm volatile("s_waitcnt lgkmcnt(0)" ::: "memory"); __builtin_amdgcn_s_barrier(); asm volatile("" ::: "memory");
#if defined(BROKEN_EXCHANGE_NO_WAIT)
#warning BROKEN CONTROL BUILD: the row-statistics exchange does not wait; results are wrong by design
        if (blockIdx.x >= 64) { const long long t0_ = clock64(); while (clock64() - t0_ < 60000) __builtin_amdgcn_s_sleep(8); }
#endif
        const int row = wid * 32 + (lane & 31);
        if (lane < 32) {
            const f32x2v a = P[row * 4 + 0], b = P[row * 4 + 1], c = P[row * 4 + 2], d = P[row * 4 + 3];
            const float mt = (a.x + b.x + c.x + d.x) * 0.25f;
            const float da = a.x - mt, db = b.x - mt, dc = c.x - mt, dd = d.x - mt;
            const float m2 = (a.y + b.y) + (c.y + d.y) + 64.0f * ((da * da + db * db) + (dc * dc + dd * dd));
            unsigned long long* slot = (unsigned long long*)xbuf + ((size_t)(u.pm * BM + row) * 4 + u.pn);
            __hip_atomic_store(slot, ((unsigned long long)__float_as_uint(m2) << 32) | __float_as_uint(mt), __ATOMIC_RELAXED, __HIP_MEMORY_SCOPE_AGENT);
        }
        asm volatile("s_waitcnt vmcnt(0)" ::: "memory");
        if (lane == 0) __hip_atomic_fetch_add(cnt + 64 * u.pm, 1u, __ATOMIC_RELAXED, __HIP_MEMORY_SCOPE_AGENT);
        if (wid == 0) {
            bool dead = false; const unsigned long long t0 = __builtin_amdgcn_s_memrealtime(); const unsigned want = 8u * (unsigned)ntn;
            for (;;) {
#if defined(BROKEN_EXCHANGE_NO_WAIT)
                break;
#endif
                if ((unsigned)__builtin_amdgcn_readfirstlane(__hip_atomic_load(cnt + 64 * u.pm, __ATOMIC_RELAXED, __HIP_MEMORY_SCOPE_AGENT)) >= want) break;
                if (__builtin_amdgcn_s_memrealtime() - t0 > 2000000ull) {
                    if (lane == 0) { unsigned expect = 0u; __hip_atomic_compare_exchange_strong(tmo + 1, &expect, code | (unsigned)(u.pm & 0xff), __ATOMIC_RELAXED, __ATOMIC_RELAXED, __HIP_MEMORY_SCOPE_AGENT);
                                     __hip_atomic_store(tmo, 1u, __ATOMIC_RELAXED, __HIP_MEMORY_SCOPE_AGENT); }
                    dead = true; break; }
                __builtin_amdgcn_s_sleep(2);
            }
            __builtin_amdgcn_fence(__ATOMIC_ACQUIRE, "agent");
            if (lane == 0) flag[0] = dead ? 1u : 0u;
        }
        asm volatile("s_waitcnt vmcnt(0) lgkmcnt(0)" ::: "memory"); __builtin_amdgcn_s_barrier(); asm volatile("" ::: "memory");
        const bool bad = flag[0] != 0u;
        if (lane < 32) {
            const unsigned long long* slot = (const unsigned long long*)xbuf + (size_t)(u.pm * BM + row) * 4; float mt[4], m2[4]; float ms = 0.f;
#pragma unroll
            for (int t = 0; t < 4; ++t) { if (t < ntn) { const unsigned long long w = __hip_atomic_load(slot + t, __ATOMIC_RELAXED, __HIP_MEMORY_SCOPE_AGENT); mt[t] = __uint_as_float((unsigned)w); m2[t] = __uint_as_float((unsigned)(w >> 32)); } else { mt[t] = 0.f; m2[t] = 0.f; } ms += mt[t]; }
            const float mean = ms / (float)ntn; float q = 0.f;
#pragma unroll
            for (int t = 0; t < 4; ++t) if (t < ntn) { const float dm = mt[t] - mean; q += m2[t] + 256.0f * dm * dm; }
            S[row] = (f32x2v){mean, 1.0f / sqrtf(q / (256.0f * (float)ntn) + eps)};
        }
        asm volatile("s_waitcnt lgkmcnt(0)" ::: "memory"); __builtin_amdgcn_s_barrier(); asm volatile("" ::: "memory");
        return bad;
    }
};
struct EpiLnRes {
    static constexpr bool PERM = false, AFTER_DRAIN = true;
    const float* base; float* out; int ldc; const float* bias; PanelStats st; unsigned poison;
    __device__ __forceinline__ void fused(f32x4 (&acc)[2][2][4][2], const Unit& u, int wr, int wc, int fr, int fq, PG8_LAS unsigned char* lds, int wid, int lane) const {
        typedef float f32x2v __attribute__((ext_vector_type(2)));
        const PG8_LAS f32x2v* S = (const PG8_LAS f32x2v*)(lds + 8192);
        const int col0 = u.pn * BM + wc * 32 + 4 * fq;
#pragma unroll
        for (int bj = 0; bj < 2; ++bj)
#pragma unroll
            for (int n = 0; n < 2; ++n) { const f32x4 bv = bias ? *(const f32x4*)(bias + col0 + bj * HALF + n * 16) : (f32x4){0.f, 0.f, 0.f, 0.f};
#pragma unroll
                for (int ai = 0; ai < 2; ++ai)
#pragma unroll
                    for (int m = 0; m < 4; ++m) acc[ai][bj][m][n] += bv; }
        f32x4 pre[4][2][2];
#pragma unroll
        for (int m = 0; m < 4; ++m) { const size_t off = (size_t)(u.pm * BM + wr * 64 + m * 16 + fr) * ldc + col0;
#pragma unroll
            for (int bj = 0; bj < 2; ++bj)
#pragma unroll
                for (int n = 0; n < 2; ++n) pre[m][bj][n] = *(const f32x4*)(base + off + bj * HALF + n * 16); }
        const bool bad = st.run(acc, u, wr, wc, fr, fq, lds, wid, lane) || poison != 0u;
        const float qnan = __builtin_nanf("");
#pragma unroll
        for (int ai = 0; ai < 2; ++ai)
#pragma unroll
            for (int m = 0; m < 4; ++m) { const int r = ai * HALF + wr * 64 + m * 16 + fr; const f32x2v sr = S[r]; const size_t off = (size_t)(u.pm * BM + r) * ldc + col0;
#pragma unroll
                for (int bj = 0; bj < 2; ++bj)
#pragma unroll
                    for (int n = 0; n < 2; ++n) { const f32x4 bs = ai == 0 ? pre[m][bj][n] : *(const f32x4*)(base + off + bj * HALF + n * 16); f32x4 o = bs + (acc[ai][bj][m][n] - sr.x) * sr.y;
                        if (bad) o = (f32x4){qnan, qnan, qnan, qnan}; *(f32x4*)(out + off + bj * HALF + n * 16) = o; }
                if (m & 1) asm volatile("" ::: "memory"); }
    }
};
struct EpiLnResLn {
    static constexpr bool PERM = false, AFTER_DRAIN = true;
    const float* base; float* out; bf16_t* xn; int ldc; const float* bias; PanelStats st1, st2; unsigned poison;
    __device__ __forceinline__ void fused(f32x4 (&acc)[2][2][4][2], const Unit& u, int wr, int wc, int fr, int fq, PG8_LAS unsigned char* lds, int wid, int lane) const {
        typedef float f32x2v __attribute__((ext_vector_type(2))); typedef unsigned u32x2v __attribute__((ext_vector_type(2)));
        const PG8_LAS f32x2v* S = (const PG8_LAS f32x2v*)(lds + 8192);
        const int col0 = u.pn * BM + wc * 32 + 4 * fq;
#pragma unroll
        for (int bj = 0; bj < 2; ++bj)
#pragma unroll
            for (int n = 0; n < 2; ++n) { const f32x4 bv = bias ? *(const f32x4*)(bias + col0 + bj * HALF + n * 16) : (f32x4){0.f, 0.f, 0.f, 0.f};
#pragma unroll
                for (int ai = 0; ai < 2; ++ai)
#pragma unroll
                    for (int m = 0; m < 4; ++m) acc[ai][bj][m][n] += bv; }
        bool bad = st1.run(acc, u, wr, wc, fr, fq, lds, wid, lane) || poison != 0u;
        const float qnan = __builtin_nanf("");
#pragma unroll
        for (int ai = 0; ai < 2; ++ai)
#pragma unroll
            for (int m = 0; m < 4; ++m) { const int r = ai * HALF + wr * 64 + m * 16 + fr; const f32x2v sr = S[r]; const size_t off = (size_t)(u.pm * BM + r) * ldc + col0;
#pragma unroll
                for (int bj = 0; bj < 2; ++bj)
#pragma unroll
                    for (int n = 0; n < 2; ++n) { const f32x4 bs = *(const f32x4*)(base + off + bj * HALF + n * 16); acc[ai][bj][m][n] = bs + (acc[ai][bj][m][n] - sr.x) * sr.y; }
                asm volatile("" : "+v"(acc[ai][0][m][0]), "+v"(acc[ai][0][m][1]), "+v"(acc[ai][1][m][0]), "+v"(acc[ai][1][m][1]));
                if (m & 1) asm volatile("" ::: "memory"); }
        const bool bad1 = bad;
        bad = st2.run(acc, u, wr, wc, fr, fq, lds, wid, lane) || bad;
#pragma unroll
        for (int ai = 0; ai < 2; ++ai)
#pragma unroll
            for (int m = 0; m < 4; ++m) { const int r = ai * HALF + wr * 64 + m * 16 + fr; const f32x2v sr = S[r]; const size_t off = (size_t)(u.pm * BM + r) * ldc + col0;
#pragma unroll
                for (int bj = 0; bj < 2; ++bj)
#pragma unroll
                    for (int n = 0; n < 2; ++n) { const f32x4 x1 = acc[ai][bj][m][n]; *(f32x4*)(out + off + bj * HALF + n * 16) = bad1 ? (f32x4){qnan, qnan, qnan, qnan} : x1;
                        const f32x4 o = (x1 - sr.x) * sr.y; u32x2v w; w.x = cvt_pk_bf16(o[0], o[1]); w.y = cvt_pk_bf16(o[2], o[3]);
                        if (bad) { w.x = 0x7fc07fc0u; w.y = 0x7fc07fc0u; } *(u32x2v*)(xn + off + bj * HALF + n * 16) = w; }
                asm volatile("" ::: "memory"); }
    }
};

template <class Epi, class Sched, bool ALIGN_EPI = false, bool SP2 = false>
__device__ __forceinline__ void gemm_phase(PG8_LAS unsigned char* lds, const Gemm g, const Sched& S, const Epi& E) {
    const int tid = threadIdx.x, wid = __builtin_amdgcn_readfirstlane(tid >> 6), lane = tid & 63, wr = wid >> 2, wc = wid & 3, fr = lane & 15, fq = lane >> 4;
    const int K = g.K, nt = K / BK;
    unsigned voffA[2], voffB[2];
#pragma unroll
    for (int i = 0; i < 2; ++i) { int R, C; stage_rc(tid * 16 + i * 8192, R, C); const int Rb = Epi::PERM ? ((R & ~31) + perm32(R & 31)) : R;
        voffA[i] = (unsigned)(R * K + C) * 2u; voffB[i] = (unsigned)(Rb * K + C) * 2u; }
    const size_t kstep = (size_t)(BK * 2);
    const size_t hstep = (size_t)HALF * K * 2;
    const size_t tstep = 2 * hstep;
    const unsigned ldsw = (unsigned)wid * 1024u;
    const int aoff = lds_byte(wr * 64 + fr, fq * 8), boff = lds_byte(wc * 32 + fr, fq * 8);
#define PG8_SA(b, h) (((b) * 2 + (h)) * HTB)
#define PG8_SB(b, h) ((4 + (b) * 2 + (h)) * HTB)
#define PG8_STAGE(bufoff, gbase, voff) do { _Pragma("unroll") for (int _i = 0; _i < 2; ++_i) \
        __builtin_amdgcn_global_load_lds((const unsigned*)((const char*)(gbase) + (voff)[_i]), (PG8_LAS unsigned*)(lds + (bufoff) + ldsw + _i * 8192), 16, 0, 0); } while (0)
#define PG8_LDA(dst, b, h) do { _Pragma("unroll") for (int m = 0; m < 4; ++m) _Pragma("unroll") for (int k = 0; k < 2; ++k) dst[m][k] = *(const PG8_LAS bf16x8*)(lds + PG8_SA(b, h) + aoff + m * 2048 + k * 1024); } while (0)
#define PG8_LDB(dst, b, h) do { _Pragma("unroll") for (int n = 0; n < 2; ++n) _Pragma("unroll") for (int k = 0; k < 2; ++k) dst[n][k] = *(const PG8_LAS bf16x8*)(lds + PG8_SB(b, h) + boff + n * 2048 + k * 1024); } while (0)
#define PG8_MMA(ai, bj, At, Bt) do { __builtin_amdgcn_s_setprio(1); _Pragma("unroll") for (int m = 0; m < 4; ++m) _Pragma("unroll") for (int n = 0; n < 2; ++n) _Pragma("unroll") for (int k = 0; k < 2; ++k) \
        acc[ai][bj][m][n] = __builtin_amdgcn_mfma_f32_16x16x32_bf16(Bt[n][k], At[m][k], acc[ai][bj][m][n], 0, 0, 0); __builtin_amdgcn_s_setprio(0); } while (0)
#define PG8_WAIT_V(n) asm volatile("s_waitcnt vmcnt(" #n ")" ::: "memory")
#define PG8_WAIT_L(n) asm volatile("s_waitcnt lgkmcnt(" #n ")" ::: "memory")
#define PG8_BAR __builtin_amdgcn_s_barrier()
#define PG8_SCHED __builtin_amdgcn_sched_barrier(0)
    Unit cur, nxt; int ui = 0;
    if (!S.next(0, cur)) return;
    f32x4 acc[2][2][4][2];
#pragma unroll
    for (int a = 0; a < 2; ++a)
#pragma unroll
        for (int b = 0; b < 2; ++b)
#pragma unroll
            for (int m = 0; m < 4; ++m)
#pragma unroll
                for (int n = 0; n < 2; ++n) acc[a][b][m][n] = (f32x4){0.f, 0.f, 0.f, 0.f};
    bf16x8 At[4][2], B0[2][2], B1[2][2];
    const char* cA = (const char*)g.A + (size_t)cur.pm * tstep; const char* cB = (const char*)g.Bt + (size_t)cur.pn * tstep;
    S.a_ready(cur);
    if constexpr (SP2) {
        PG8_STAGE(PG8_SB(0, 0), cB, voffB); PG8_STAGE(PG8_SB(0, 1), cB + hstep, voffB); PG8_STAGE(PG8_SA(0, 0), cA, voffA); PG8_STAGE(PG8_SA(0, 1), cA + hstep, voffA);
        if (wr == 1) PG8_BAR;
        PG8_WAIT_V(2); PG8_BAR;
        PG8_STAGE(PG8_SB(1, 0), cB + kstep, voffB); PG8_STAGE(PG8_SA(1, 0), cA + kstep, voffA); PG8_STAGE(PG8_SB(1, 1), cB + hstep + kstep, voffB);
        PG8_WAIT_V(6); PG8_BAR;
    } else {
        PG8_STAGE(PG8_SB(0, 0), cB, voffB); PG8_STAGE(PG8_SA(0, 0), cA, voffA); PG8_STAGE(PG8_SB(0, 1), cB + hstep, voffB); PG8_STAGE(PG8_SA(0, 1), cA + hstep, voffA);
        if (wr == 1) PG8_BAR;
        PG8_WAIT_V(4); PG8_BAR;
        PG8_STAGE(PG8_SB(1, 0), cB + kstep, voffB); PG8_STAGE(PG8_SA(1, 0), cA + kstep, voffA); PG8_STAGE(PG8_SB(1, 1), cB + hstep + kstep, voffB);
        PG8_WAIT_V(6); PG8_BAR;
    }
    for (;;) {
        const bool has_next = S.next(ui + 1, nxt);
        const char* nA = has_next ? (const char*)g.A + (size_t)nxt.pm * tstep : cA; const char* nB = has_next ? (const char*)g.Bt + (size_t)nxt.pn * tstep : cB;
        for (int t = 0; t < nt; t += 2) {
            const bool last = (t == nt - 2);
            const char* a1 = cA + (size_t)(t + 1) * kstep;
            const char* a2 = last ? nA : cA + (size_t)(t + 2) * kstep; const char* b2 = last ? nB : cB + (size_t)(t + 2) * kstep;
            const char* a3 = a2 + kstep; const char* b3 = b2 + kstep;
            if (last && has_next) S.a_ready(nxt);
            if constexpr (SP2) {
            PG8_LDB(B0, 0, 0); PG8_LDB(B1, 0, 1); PG8_SCHED; PG8_LDA(At, 0, 0); PG8_STAGE(PG8_SA(1, 1), a1 + hstep, voffA);
            PG8_WAIT_V(8); PG8_WAIT_L(0); PG8_BAR; PG8_MMA(0, 0, At, B0); PG8_MMA(0, 1, At, B1); PG8_BAR; PG8_SCHED;
            PG8_LDA(At, 0, 1); PG8_STAGE(PG8_SB(0, 0), b2, voffB); PG8_STAGE(PG8_SB(0, 1), b2 + hstep, voffB); PG8_STAGE(PG8_SA(0, 0), a2, voffA);
            PG8_WAIT_V(8); PG8_WAIT_L(0); PG8_BAR; PG8_MMA(1, 0, At, B0); PG8_MMA(1, 1, At, B1); PG8_BAR; PG8_SCHED;
            PG8_LDB(B0, 1, 0); PG8_LDB(B1, 1, 1); PG8_SCHED; PG8_LDA(At, 1, 0); PG8_STAGE(PG8_SA(0, 1), a2 + hstep, voffA);
            PG8_WAIT_V(8); PG8_WAIT_L(0); PG8_BAR; PG8_MMA(0, 0, At, B0); PG8_MMA(0, 1, At, B1); PG8_BAR; PG8_SCHED;
            PG8_LDA(At, 1, 1); PG8_STAGE(PG8_SB(1, 0), b3, voffB); PG8_STAGE(PG8_SB(1, 1), b3 + hstep, voffB); PG8_STAGE(PG8_SA(1, 0), a3, voffA);
            PG8_WAIT_V(8); PG8_WAIT_L(0); PG8_BAR; PG8_MMA(1, 0, At, B0); PG8_MMA(1, 1, At, B1); PG8_BAR; PG8_SCHED;
            } else {
            PG8_LDB(B0, 0, 0); PG8_SCHED; PG8_LDA(At, 0, 0); PG8_STAGE(PG8_SA(1, 1), a1 + hstep, voffA);
            PG8_WAIT_L(8); PG8_BAR; PG8_WAIT_L(0); PG8_MMA(0, 0, At, B0); PG8_BAR; PG8_SCHED;
            PG8_LDB(B1, 0, 1); PG8_STAGE(PG8_SB(0, 0), b2, voffB);
            PG8_BAR; PG8_WAIT_L(0); PG8_MMA(0, 1, At, B1); PG8_BAR;
            PG8_LDA(At, 0, 1); PG8_STAGE(PG8_SA(0, 0), a2, voffA);
            PG8_BAR; PG8_WAIT_L(0); PG8_MMA(1, 0, At, B0); PG8_BAR; PG8_SCHED;
            PG8_STAGE(PG8_SB(0, 1), b2 + hstep, voffB);
            PG8_WAIT_V(6); PG8_BAR; PG8_MMA(1, 1, At, B1); PG8_BAR;
            PG8_LDB(B0, 1, 0); PG8_SCHED; PG8_LDA(At, 1, 0); PG8_STAGE(PG8_SA(0, 1), a2 + hstep, voffA);
            PG8_WAIT_L(8); PG8_BAR; PG8_WAIT_L(0); PG8_MMA(0, 0, At, B0); PG8_BAR; PG8_SCHED;
            PG8_LDB(B1, 1, 1); PG8_STAGE(PG8_SB(1, 0), b3, voffB);
            PG8_BAR; PG8_WAIT_L(0); PG8_MMA(0, 1, At, B1); PG8_BAR;
            PG8_LDA(At, 1, 1); PG8_STAGE(PG8_SA(1, 0), a3, voffA);
            PG8_BAR; PG8_WAIT_L(0); PG8_MMA(1, 0, At, B0); PG8_BAR; PG8_SCHED;
            PG8_STAGE(PG8_SB(1, 1), b3 + hstep, voffB);
            PG8_WAIT_V(6); PG8_BAR; PG8_MMA(1, 1, At, B1); PG8_BAR;
            }
        }
        if constexpr (ALIGN_EPI) { if (wr == 0) PG8_BAR; }
        if constexpr (!Epi::AFTER_DRAIN) { E(acc, cur, wr, wc, fr, fq); S.done(cur); }
        if (!has_next) break;
#pragma unroll
        for (int a = 0; a < 2; ++a)
#pragma unroll
            for (int b = 0; b < 2; ++b)
#pragma unroll
                for (int m = 0; m < 4; ++m)
#pragma unroll
                    for (int n = 0; n < 2; ++n) acc[a][b][m][n] = (f32x4){0.f, 0.f, 0.f, 0.f};
        cur = nxt; cA = nA; cB = nB; ++ui;
        if constexpr (ALIGN_EPI) { if (wr == 1) PG8_BAR; }
    }
    PG8_WAIT_V(0);
    if constexpr (!ALIGN_EPI) { if (wr == 0) PG8_BAR; }
    PG8_BAR;
    if constexpr (Epi::AFTER_DRAIN) { E.fused(acc, cur, wr, wc, fr, fq, lds, wid, lane); S.done(cur); }
#undef PG8_SA
#undef PG8_SB
#undef PG8_STAGE
#undef PG8_LDA
#undef PG8_LDB
#undef PG8_MMA
#undef PG8_WAIT_V
#undef PG8_WAIT_L
#undef PG8_BAR
#undef PG8_SCHED
}
}
constexpr int BATCH = 4, SEQ = 4096, DM = 1024, MROWS = BATCH * SEQ;
constexpr int NMEM = 256, MEMROWS = BATCH * NMEM;
constexpr int PP = 3584;
constexpr int INW = 3592, DFF = 2816;
constexpr int C_RQ = 0, C_RK = 512, C_RV = 1024, C_RG = 1536, C_FQ = 2048, C_FK = 2560, C_FV = 3072;
constexpr float EPS = 1e-6f, LOG2E = 1.4426950408889634f;
constexpr float C2F = 0.125f * LOG2E;
constexpr int NTHR = 512, NWAVES = 8;
constexpr int LDS_BYTES = 147456;

constexpr size_t MiB = 1u << 20;
constexpr size_t WS_WIN = 2 * MiB, WS_WOUT = 10 * MiB, WS_WXQ = 12 * MiB, WS_WXKV = 14 * MiB, WS_WXO = 18 * MiB, WS_WGU = 20 * MiB, WS_WD = 32 * MiB;
constexpr size_t WS_COS = 38 * MiB, WS_SIN = 38 * MiB + 512 * 1024, WS_LOGF = 39 * MiB, WS_FC = 39 * MiB + 512 * 1024;
constexpr size_t WS_MEMN = 40 * MiB, WS_KVM = 42 * MiB, WS_KSS = 46 * MiB, WS_SS1 = 47 * MiB, WS_QSS = 48 * MiB, WS_SS2 = 49 * MiB;
constexpr size_t WS_HN = 64 * MiB;
constexpr size_t WS_P = 96 * MiB;
constexpr size_t WS_KVT = 208 * MiB;
constexpr size_t WS_ST = 240 * MiB;
constexpr size_t WS_H1B = 96 * MiB;
constexpr size_t WS_QX = 128 * MiB;
constexpr size_t WS_O = 160 * MiB;
constexpr size_t WS_ACT = 128 * MiB;
constexpr size_t WS_END = 256 * MiB;

typedef unsigned short bf16_t;
typedef short bf16x8 __attribute__((ext_vector_type(8)));
typedef short s16x4 __attribute__((ext_vector_type(4)));
typedef float f32x4 __attribute__((ext_vector_type(4)));
typedef float f32x16 __attribute__((ext_vector_type(16)));
typedef unsigned u32x4 __attribute__((ext_vector_type(4)));
typedef unsigned u32x2 __attribute__((ext_vector_type(2)));
#define LAS __attribute__((address_space(3)))
typedef LAS unsigned char* ldsp_t;

__device__ __forceinline__ unsigned pkbf(float lo, float hi) {
    typedef float f2 __attribute__((ext_vector_type(2))); typedef __bf16 b2 __attribute__((ext_vector_type(2)));
    f2 v = {lo, hi}; b2 b = __builtin_convertvector(v, b2); return __builtin_bit_cast(unsigned, b);
}
__device__ __forceinline__ void st16(void* ptr, u32x4 v) { *(u32x4*)ptr = v; }
__device__ __forceinline__ void st16f(void* ptr, f32x4 v) { *(f32x4*)ptr = v; }
__device__ __forceinline__ void st8(void* ptr, u32x2 v) { *(u32x2*)ptr = v; }
__device__ __forceinline__ float bflo(unsigned u) { return __uint_as_float(u << 16); }
__device__ __forceinline__ float bfhi(unsigned u) { return __uint_as_float(u & 0xffff0000u); }
__device__ __forceinline__ int crow(int r, int hi) { return (r & 3) + 8 * (r >> 2) + 4 * hi; }
__device__ __forceinline__ float wave_sum(float v) {
#pragma unroll
    for (int o = 1; o < 64; o <<= 1) v += __shfl_xor(v, o);
    return v;
}
__device__ __forceinline__ s16x4 tr_rd(ldsp_t p) {
    typedef short v4i16_t __attribute__((ext_vector_type(4)));
    return __builtin_bit_cast(s16x4, __builtin_amdgcn_ds_read_tr16_b64_v4i16((LAS v4i16_t*)p));
}
__device__ __forceinline__ bf16x8 cat8(s16x4 lo, s16x4 hi) { return __builtin_shufflevector(lo, hi, 0, 1, 2, 3, 4, 5, 6, 7); }
#define MFMA32(a, b, c) __builtin_amdgcn_mfma_f32_32x32x16_bf16((a), (b), (c), 0, 0, 0)
__device__ __forceinline__ bf16x8 pack8(const f32x16& x, int s) {
    u32x4 p; p.x = pkbf(x[8 * s], x[8 * s + 1]); p.y = pkbf(x[8 * s + 2], x[8 * s + 3]); p.z = pkbf(x[8 * s + 4], x[8 * s + 5]); p.w = pkbf(x[8 * s + 6], x[8 * s + 7]);
    return __builtin_bit_cast(bf16x8, p);
}


#define GAS __attribute__((address_space(1)))
#define XB_TMO      128
#define XB_XCNT(j)  (256  + 64 * (j))
#define XB_XSUB(j)  (1280 + 64 * (j))
#define XB_XGEN(j)  (2304 + 64 * (j))
#define XB_TOP      3328
#define XB_TOPGEN   3392
#define XCD_BAR_WORDS 3456
#define XB_SPIN_CAP (1u << 18)

__device__ __forceinline__ unsigned xb_ld(unsigned* p)              { return __hip_atomic_load(p, __ATOMIC_RELAXED, __HIP_MEMORY_SCOPE_AGENT); }
__device__ __forceinline__ unsigned xb_add(unsigned* p, unsigned v) { return __hip_atomic_fetch_add(p, v, __ATOMIC_RELAXED, __HIP_MEMORY_SCOPE_AGENT); }
__device__ __forceinline__ unsigned xb_xcc_id() { return (unsigned)__builtin_amdgcn_s_getreg((3 << 11) | 20) & 0xFu; }
#define XB_SPIN(cond, bar) do { unsigned _sp = 0; while (cond) {   \
    if ((++_sp & 255u) == 0u) { if (xb_ld(&(bar)[XB_TMO])) break; if (_sp > XB_SPIN_CAP) { atomicAdd(&(bar)[XB_TMO], 1u); break; } } } } while (0)

struct XcdBarrier {
    unsigned* bar; unsigned x;
    volatile LAS unsigned* st;
};

__device__ __forceinline__ XcdBarrier xcd_barrier_post(unsigned* bar, volatile LAS unsigned* st) {
    XcdBarrier b; b.bar = bar; b.x = xb_xcc_id(); b.st = st;
    if (threadIdx.x == 0) (void)xb_add(&bar[XB_XCNT(b.x)], 1u);
    return b;
}
__device__ __forceinline__ void xcd_barrier_complete(unsigned* bar, unsigned x, unsigned& nloc, unsigned& nx) {
    const unsigned G = gridDim.x * gridDim.y * gridDim.z;
    unsigned sum, cnt, mine, sp = 0u;
    for (;;) {
        sum = 0u; cnt = 0u; mine = 0u;
#pragma unroll
        for (unsigned j = 0; j < 16; ++j) { const unsigned c = xb_ld(&bar[XB_XCNT(j)]); sum += c; cnt += (c > 0u) ? 1u : 0u; mine = (j == x) ? c : mine; }
        if (sum == G) break;
        __builtin_amdgcn_s_sleep(1);
        if ((++sp & 255u) == 0u) { if (xb_ld(&bar[XB_TMO])) break; if (sp > XB_SPIN_CAP) { atomicAdd(&bar[XB_TMO], 1u); break; } }
    }
    nloc = mine > 0u ? mine : 1u; nx = cnt > 0u ? cnt : 1u;
}

__device__ __forceinline__ void xcd_barrier(const XcdBarrier& b) {
    asm volatile("s_waitcnt vmcnt(0)" ::: "memory");
    __syncthreads();
    if (threadIdx.x == 0) {
        unsigned* bar = b.bar;
        __builtin_amdgcn_s_waitcnt(0);
        unsigned nloc = b.st[0], nx = b.st[1];
        if (nloc == 0u) { xcd_barrier_complete(bar, b.x, nloc, nx); b.st[0] = nloc; b.st[1] = nx; }
        const unsigned old = xb_add(&bar[XB_XSUB(b.x)], 1u);
        const unsigned gen = old / nloc;
        if (old + 1u == (gen + 1u) * nloc) {
            __builtin_amdgcn_fence(__ATOMIC_RELEASE, "agent");
            asm volatile("s_waitcnt vmcnt(0)" ::: "memory");
            const unsigned og = xb_add(&bar[XB_TOP], 1u);
            const unsigned tg = og / nx;
            if (og + 1u == (tg + 1u) * nx) xb_add(&bar[XB_TOPGEN], 1u);
            else XB_SPIN(xb_ld(&bar[XB_TOPGEN]) == tg, bar);
            xb_add(&bar[XB_XGEN(b.x)], 1u);
            __builtin_amdgcn_fence(__ATOMIC_ACQUIRE, "agent");
            asm volatile("s_waitcnt vmcnt(0)" ::: "memory");
        } else {
            XB_SPIN(xb_ld(&bar[XB_XGEN(b.x)]) == gen, bar);
            __builtin_amdgcn_fence(__ATOMIC_ACQUIRE, "agent");
            asm volatile("s_waitcnt vmcnt(0)" ::: "memory");
        }
    }
    __syncthreads();
}


namespace pg8 {
struct EpiProj {
    static constexpr bool PERM = true, AFTER_DRAIN = false;
    bf16_t* P; const float* cs; const float* sn; const float* gq; const float* gk;
    __device__ __forceinline__ void operator()(const f32x4 (&acc)[2][2][4][2], const Unit& u, int wr, int wc, int fr, int fq) const {
        const int seg = u.pn >> 1;
        const int row0 = u.pm * BM + wr * 64 + fr;
        const int colbase = u.pn * 256 + 64 * wc + 8 * fq;
        if (seg == 0 || seg == 1) {
#pragma unroll
            for (int ai = 0; ai < 2; ++ai)
#pragma unroll
                for (int m = 0; m < 4; ++m) {
                    const int row = row0 + ai * HALF + m * 16; const int pos = row & (SEQ - 1);
                    const float* cp = cs + pos * 32 + 8 * fq; const float* sp = sn + pos * 32 + 8 * fq;
                    u32x4 w1, w2;
                    { const f32x4 c = *(const f32x4*)cp, s = *(const f32x4*)sp; const f32x4 x1 = acc[ai][0][m][0], x2 = acc[ai][1][m][0];
                      const f32x4 o1 = x1 * c - x2 * s, o2 = x1 * s + x2 * c; w1.x = pkbf(o1[0], o1[1]); w1.y = pkbf(o1[2], o1[3]); w2.x = pkbf(o2[0], o2[1]); w2.y = pkbf(o2[2], o2[3]); }
                    { const f32x4 c = *(const f32x4*)(cp + 4), s = *(const f32x4*)(sp + 4); const f32x4 x1 = acc[ai][0][m][1], x2 = acc[ai][1][m][1];
                      const f32x4 o1 = x1 * c - x2 * s, o2 = x1 * s + x2 * c; w1.z = pkbf(o1[0], o1[1]); w1.w = pkbf(o1[2], o1[3]); w2.z = pkbf(o2[0], o2[1]); w2.w = pkbf(o2[2], o2[3]); }
                    bf16_t* rp = P + (size_t)row * PP + colbase;
                    st16(rp, w1); st16(rp + 32, w2);
                }
        } else if (seg == 4 || seg == 5) {
            const float* g = (seg == 4) ? gq : gk; const float sc = (seg == 4) ? C2F : 1.0f;
            f32x4 gv[2][2];
#pragma unroll
            for (int bj = 0; bj < 2; ++bj)
#pragma unroll
                for (int n = 0; n < 2; ++n) gv[bj][n] = *(const f32x4*)(g + 32 * bj + 8 * fq + 4 * n);
#pragma unroll
            for (int ai = 0; ai < 2; ++ai)
#pragma unroll
                for (int m = 0; m < 4; ++m) {
                    const int row = row0 + ai * HALF + m * 16;
                    float ss = 0.f;
#pragma unroll
                    for (int bj = 0; bj < 2; ++bj)
#pragma unroll
                        for (int n = 0; n < 2; ++n) { const f32x4 x = acc[ai][bj][m][n]; ss += (x[0] * x[0] + x[1] * x[1]) + (x[2] * x[2] + x[3] * x[3]); }
                    ss += __shfl_xor(ss, 16); ss += __shfl_xor(ss, 32);
                    const float rs = rsqrtf(ss * (1.0f / 64.0f) + EPS) * sc;
                    bf16_t* rp = P + (size_t)row * PP + colbase;
#pragma unroll
                    for (int bj = 0; bj < 2; ++bj) { const f32x4 a = acc[ai][bj][m][0] * gv[bj][0] * rs, b = acc[ai][bj][m][1] * gv[bj][1] * rs;
                        u32x4 w; w.x = pkbf(a[0], a[1]); w.y = pkbf(a[2], a[3]); w.z = pkbf(b[0], b[1]); w.w = pkbf(b[2], b[3]); st16(rp + 32 * bj, w); }
                }
        } else {
#pragma unroll
            for (int ai = 0; ai < 2; ++ai)
#pragma unroll
                for (int m = 0; m < 4; ++m) {
                    const int row = row0 + ai * HALF + m * 16; bf16_t* rp = P + (size_t)row * PP + colbase;
#pragma unroll
                    for (int bj = 0; bj < 2; ++bj) { const f32x4 a = acc[ai][bj][m][0], b = acc[ai][bj][m][1];
                        u32x4 w; w.x = pkbf(a[0], a[1]); w.y = pkbf(a[2], a[3]); w.z = pkbf(b[0], b[1]); w.w = pkbf(b[2], b[3]); st16(rp + 32 * bj, w); }
                }
        }
    }
};
struct EpiKV {
    static constexpr bool PERM = true, AFTER_DRAIN = false;
    bf16_t* O; float* kss; const float* gxq; const float* gxk;
    __device__ __forceinline__ void operator()(const f32x4 (&acc)[2][2][4][2], const Unit& u, int wr, int wc, int fr, int fq) const {
        const int row0 = u.pm * BM + wr * 64 + fr; const int col0 = u.pn * BM + wc * 32 + 8 * fq; const bool isk = u.pn < 4;
        f32x4 gv[2][2];
#pragma unroll
        for (int bj = 0; bj < 2; ++bj)
#pragma unroll
            for (int n = 0; n < 2; ++n) { const int c = (col0 + bj * HALF + 4 * n) & 255;
                gv[bj][n] = isk ? (*(const f32x4*)(gxq + c)) * (*(const f32x4*)(gxk + c)) : (f32x4){1.f, 1.f, 1.f, 1.f}; }
#pragma unroll
        for (int ai = 0; ai < 2; ++ai)
#pragma unroll
            for (int m = 0; m < 4; ++m) {
                const int row = row0 + ai * HALF + m * 16; float ss = 0.f;
                bf16_t* rp = O + (size_t)row * 2048 + col0;
#pragma unroll
                for (int bj = 0; bj < 2; ++bj) { const f32x4 a0 = acc[ai][bj][m][0], b0 = acc[ai][bj][m][1];
                    ss += (a0[0] * a0[0] + a0[1] * a0[1]) + (a0[2] * a0[2] + a0[3] * a0[3]) + (b0[0] * b0[0] + b0[1] * b0[1]) + (b0[2] * b0[2] + b0[3] * b0[3]);
                    const f32x4 a = a0 * gv[bj][0], b = b0 * gv[bj][1];
                    u32x4 w; w.x = pkbf(a[0], a[1]); w.y = pkbf(a[2], a[3]); w.z = pkbf(b[0], b[1]); w.w = pkbf(b[2], b[3]); st16(rp + bj * HALF, w); }
                ss += __shfl_xor(ss, 16); ss += __shfl_xor(ss, 32);
                if (isk && fq == 0) kss[(size_t)row * 16 + u.pn * 4 + wc] = ss;
            }
    }
};
template <bool BB> struct EpiRes {
    static constexpr bool PERM = true, AFTER_DRAIN = false;
    const void* base; float* out; bf16_t* hb; float* ssp;
    __device__ __forceinline__ void operator()(const f32x4 (&acc)[2][2][4][2], const Unit& u, int wr, int wc, int fr, int fq) const {
        const int row0 = u.pm * BM + wr * 64 + fr; const int col0 = u.pn * BM + wc * 32 + 8 * fq;
#pragma unroll
        for (int ai = 0; ai < 2; ++ai) {
            f32x4 rb[4][2][2];
#pragma unroll
            for (int m = 0; m < 4; ++m) { const size_t off = (size_t)(row0 + ai * HALF + m * 16) * DM + col0;
#pragma unroll
                for (int bj = 0; bj < 2; ++bj) {
                    if constexpr (BB) { const u32x4 w = *(const u32x4*)((const bf16_t*)base + off + bj * HALF);
                        rb[m][bj][0] = (f32x4){bflo(w.x), bfhi(w.x), bflo(w.y), bfhi(w.y)}; rb[m][bj][1] = (f32x4){bflo(w.z), bfhi(w.z), bflo(w.w), bfhi(w.w)}; }
                    else { rb[m][bj][0] = __builtin_nontemporal_load((const f32x4*)((const float*)base + off + bj * HALF)); rb[m][bj][1] = __builtin_nontemporal_load((const f32x4*)((const float*)base + off + bj * HALF + 4)); } } }
#pragma unroll
            for (int m = 0; m < 4; ++m) {
                const int row = row0 + ai * HALF + m * 16; float ss = 0.f; const size_t off = (size_t)row * DM + col0;
#pragma unroll
                for (int bj = 0; bj < 2; ++bj) {
                    const f32x4 a = rb[m][bj][0] + acc[ai][bj][m][0], b = rb[m][bj][1] + acc[ai][bj][m][1];
                    if (out) { __builtin_nontemporal_store(a, (f32x4*)(out + off + bj * HALF)); __builtin_nontemporal_store(b, (f32x4*)(out + off + bj * HALF + 4)); }
                    ss += (a[0] * a[0] + a[1] * a[1]) + (a[2] * a[2] + a[3] * a[3]) + (b[0] * b[0] + b[1] * b[1]) + (b[2] * b[2] + b[3] * b[3]);
                    if (hb) { u32x4 w; w.x = pkbf(a[0], a[1]); w.y = pkbf(a[2], a[3]); w.z = pkbf(b[0], b[1]); w.w = pkbf(b[2], b[3]); st16(hb + off + bj * HALF, w); }
                }
                if (ssp) { ss += __shfl_xor(ss, 16); ss += __shfl_xor(ss, 32); if (fq == 0) ssp[(size_t)row * 16 + u.pn * 4 + wc] = ss; }
            }
        }
    }
};
struct EpiXq {
    static constexpr bool PERM = true, AFTER_DRAIN = false;
    bf16_t* O; float* qss;
    __device__ __forceinline__ void operator()(const f32x4 (&acc)[2][2][4][2], const Unit& u, int wr, int wc, int fr, int fq) const {
        const int row0 = u.pm * BM + wr * 64 + fr; const int col0 = u.pn * BM + wc * 32 + 8 * fq;
#pragma unroll
        for (int ai = 0; ai < 2; ++ai)
#pragma unroll
            for (int m = 0; m < 4; ++m) {
                const int row = row0 + ai * HALF + m * 16; float ss = 0.f; bf16_t* rp = O + (size_t)row * DM + col0;
#pragma unroll
                for (int bj = 0; bj < 2; ++bj) { const f32x4 a = acc[ai][bj][m][0], b = acc[ai][bj][m][1];
                    ss += (a[0] * a[0] + a[1] * a[1]) + (a[2] * a[2] + a[3] * a[3]) + (b[0] * b[0] + b[1] * b[1]) + (b[2] * b[2] + b[3] * b[3]);
                    u32x4 w; w.x = pkbf(a[0], a[1]); w.y = pkbf(a[2], a[3]); w.z = pkbf(b[0], b[1]); w.w = pkbf(b[2], b[3]); st16(rp + bj * HALF, w); }
                ss += __shfl_xor(ss, 16); ss += __shfl_xor(ss, 32);
                if (fq == 0) qss[(size_t)row * 16 + u.pn * 4 + wc] = ss;
            }
    }
};
struct EpiGU {
    static constexpr bool PERM = true, AFTER_DRAIN = false;
    bf16_t* A; const float* ss2; const LAS float* rl;
    __device__ __forceinline__ void operator()(const f32x4 (&acc)[2][2][4][2], const Unit& u, int wr, int wc, int fr, int fq) const {
        const int row0 = u.pm * BM + wr * 64 + fr; const int col0 = u.pn * 128 + wc * 32 + 8 * fq;
#pragma unroll
        for (int ai = 0; ai < 2; ++ai)
#pragma unroll
            for (int m = 0; m < 4; ++m) {
                const int row = row0 + ai * HALF + m * 16;
                float r;
                if (rl) r = rl[ai * HALF + wr * 64 + m * 16 + fr];
                else { const f32x4* sp = (const f32x4*)(ss2 + (size_t)row * 16); const f32x4 s0 = sp[0], s1 = sp[1], s2 = sp[2], s3 = sp[3];
                    const float tot = ((s0[0] + s0[1]) + (s0[2] + s0[3])) + ((s1[0] + s1[1]) + (s1[2] + s1[3])) + ((s2[0] + s2[1]) + (s2[2] + s2[3])) + ((s3[0] + s3[1]) + (s3[2] + s3[3]));
                    r = rsqrtf(tot * (1.0f / 1024.0f) + EPS); }
                float o[8];
#pragma unroll
                for (int n = 0; n < 2; ++n)
#pragma unroll
                    for (int e = 0; e < 4; ++e) { const float g = acc[ai][0][m][n][e] * r, up = acc[ai][1][m][n][e] * r;
                        o[4 * n + e] = g * __builtin_amdgcn_rcpf(1.0f + __builtin_amdgcn_exp2f(-g * LOG2E)) * up; }
                u32x4 w; w.x = pkbf(o[0], o[1]); w.y = pkbf(o[2], o[3]); w.z = pkbf(o[4], o[5]); w.w = pkbf(o[6], o[7]);
                st16(A + (size_t)row * DFF + col0, w);
            }
    }
};
}

struct WItem { const float* W; const float* gain; bf16_t* WT; int ldw, src_col0, ldt, dst_row0, k0; };
__device__ __forceinline__ void witem_load(const WItem& w, f32x4 (&v)[8], int lane) {
    const int c4 = (lane & 7) * 4, kr = lane >> 3;
#pragma unroll
    for (int i = 0; i < 8; ++i) v[i] = __builtin_nontemporal_load((const f32x4*)(w.W + (size_t)(w.k0 + 8 * i + kr) * w.ldw + w.src_col0 + c4));
}
__device__ __forceinline__ void witem_finish(const WItem& w, const f32x4 (&v)[8], LAS float* scr, int lane) {
    const int c4 = (lane & 7) * 4, kr = lane >> 3;
#pragma unroll
    for (int i = 0; i < 8; ++i) { const int kk = 8 * i + kr; const float g = w.gain ? w.gain[w.k0 + kk] : 1.0f;
        scr[kk * 33 + c4] = v[i][0] * g; scr[kk * 33 + c4 + 1] = v[i][1] * g; scr[kk * 33 + c4 + 2] = v[i][2] * g; scr[kk * 33 + c4 + 3] = v[i][3] * g; }
    asm volatile("s_waitcnt lgkmcnt(0)" ::: "memory");
    const int c = lane & 7;
#pragma unroll
    for (int j = 0; j < 4; ++j) { const int n = (lane >> 3) + 8 * j; const LAS float* s = scr + (8 * c) * 33 + n;
        u32x4 o; o.x = pkbf(s[0 * 33], s[1 * 33]); o.y = pkbf(s[2 * 33], s[3 * 33]); o.z = pkbf(s[4 * 33], s[5 * 33]); o.w = pkbf(s[6 * 33], s[7 * 33]);
        *(u32x4*)(w.WT + (size_t)(w.dst_row0 + n) * w.ldt + w.k0 + 8 * c) = o; }
    asm volatile("s_waitcnt lgkmcnt(0)" ::: "memory");
}

struct Params {
    const float* in[20];
    float* out;
    unsigned char* ws;
};

constexpr int I_IN = 16 * 112, I_XKV = 16 * 64, I_OUT = 16 * 32, I_XQ = 16 * 32, I_XO = 16 * 32, I_GU = 16 * 176, I_D = 44 * 32;
#ifndef LATE_WEIGHTS
#define LATE_WEIGHTS 1
#endif
#define LATE_W (LATE_WEIGHTS && G == 256)
constexpr int W_P1 = I_IN + I_XKV, W_EARLY = W_P1 + I_D, W_ALL = W_EARLY + I_OUT + I_XQ + I_XO + I_GU;
__device__ __forceinline__ WItem witem_decode(const Params& p, int it) {
    unsigned char* ws = p.ws; WItem w; w.gain = nullptr; int r = it;
    if (r < I_IN) { const int kb = r / 112, nb = r % 112, p0 = 32 * nb, pt = p0 >> 8, pp = p0 & 255;
        w.W = p.in[3]; w.ldw = INW; w.src_col0 = 256 * pt + 64 * ((pp >> 5) & 3) + 32 * (pp >> 7); w.WT = (bf16_t*)(ws + WS_WIN); w.ldt = 1024; w.dst_row0 = p0; w.k0 = 64 * kb; return w; } r -= I_IN;
    if (r < I_XKV) { const int kb = r / 64, nb = r % 64; w.W = p.in[11]; w.ldw = 2048; w.src_col0 = 32 * nb; w.WT = (bf16_t*)(ws + WS_WXKV); w.ldt = 1024; w.dst_row0 = 32 * nb; w.k0 = 64 * kb; return w; } r -= I_XKV;
    if (r < I_D) { const int kb = r / 32, nb = r % 32; w.W = p.in[19]; w.ldw = 1024; w.src_col0 = 32 * nb; w.WT = (bf16_t*)(ws + WS_WD); w.ldt = DFF; w.dst_row0 = 32 * nb; w.k0 = 64 * kb; return w; } r -= I_D;
    if (r < I_OUT) { const int kb = r / 32, nb = r % 32; w.W = p.in[8]; w.ldw = 1024; w.src_col0 = 32 * nb; w.WT = (bf16_t*)(ws + WS_WOUT); w.ldt = 1024; w.dst_row0 = 32 * nb; w.k0 = 64 * kb; return w; } r -= I_OUT;
    if (r < I_XQ) { const int kb = r / 32, nb = r % 32; w.W = p.in[10]; w.gain = p.in[9]; w.ldw = 1024; w.src_col0 = 32 * nb; w.WT = (bf16_t*)(ws + WS_WXQ); w.ldt = 1024; w.dst_row0 = 32 * nb; w.k0 = 64 * kb; return w; } r -= I_XQ;
    if (r < I_XO) { const int kb = r / 32, nb = r % 32; w.W = p.in[15]; w.ldw = 1024; w.src_col0 = 32 * nb; w.WT = (bf16_t*)(ws + WS_WXO); w.ldt = 1024; w.dst_row0 = 32 * nb; w.k0 = 64 * kb; return w; } r -= I_XO;
    { const int kb = r / 176, nb = r % 176, p0 = 32 * nb, pt = p0 >> 8, pp = p0 & 255;
        w.W = (pp >> 7) ? p.in[18] : p.in[17]; w.gain = p.in[16]; w.ldw = DFF; w.src_col0 = 128 * pt + (pp & 127); w.WT = (bf16_t*)(ws + WS_WGU); w.ldt = 1024; w.dst_row0 = p0; w.k0 = 64 * kb; return w; }
    return w;
}

__device__ __forceinline__ void weight_items(const Params& p, LAS float* scr, int lane, int gw, int NGW, int first, int last) {
    int it = first + gw;
    if (it >= last) return;
    WItem cur = witem_decode(p, it); f32x4 v[8]; witem_load(cur, v, lane);
    for (;;) {
        const int nx = it + NGW; const bool more = nx < last;
        WItem nw = cur; f32x4 vn[8];
        if (more) { nw = witem_decode(p, nx); witem_load(nw, vn, lane); }
        witem_finish(cur, v, scr, lane);
        if (!more) break;
        cur = nw; it = nx;
#pragma unroll
        for (int i = 0; i < 8; ++i) v[i] = vn[i];
    }
}

__device__ __forceinline__ void p0_prologue(const Params& p, ldsp_t lds, int vcu, int G) {
    const int tid = threadIdx.x, lane = tid & 63, wave = __builtin_amdgcn_readfirstlane(tid >> 6);
    unsigned char* ws = p.ws;
    const float* x = p.in[0]; const float* mem = p.in[1]; const float* g_mix = p.in[2]; const float* w_in = p.in[3]; const float* b_forget = p.in[4];
    const float* w_out = p.in[8]; const float* g_xattn = p.in[9]; const float* w_xq = p.in[10]; const float* w_xkv = p.in[11]; const float* g_mem = p.in[12];
    const float* w_xo = p.in[15]; const float* g_ffn = p.in[16]; const float* w_gate = p.in[17]; const float* w_up = p.in[18]; const float* w_down = p.in[19];
    LAS float* scr = (LAS float*)(lds + wave * 8448);
    LAS float* wfT = (LAS float*)(lds + 98304);
    float wfv[16];
#pragma unroll
    for (int j = 0; j < 16; ++j) { const int i = tid + j * NTHR, k = i >> 3, c = i & 7; wfv[j] = w_in[(size_t)k * INW + 3584 + c] * g_mix[k]; }
    const int gw = vcu * NWAVES + wave, NGW = G * NWAVES;
    f32x4 gm[4], vn[4], vn2[4], mv[4];
#pragma unroll
    for (int j = 0; j < 4; ++j) gm[j] = ((const f32x4*)g_mix)[lane + 64 * j];
    if (gw < MROWS) {
#pragma unroll
        for (int j = 0; j < 4; ++j) vn[j] = __builtin_nontemporal_load((const f32x4*)(x + (size_t)gw * DM) + lane + 64 * j);
    }
    if (gw + NGW < MROWS) {
#pragma unroll
        for (int j = 0; j < 4; ++j) vn2[j] = __builtin_nontemporal_load((const f32x4*)(x + (size_t)(gw + NGW) * DM) + lane + 64 * j);
    }
    if (gw < MEMROWS) {
#pragma unroll
        for (int j = 0; j < 4; ++j) mv[j] = __builtin_nontemporal_load((const f32x4*)(mem + (size_t)gw * DM) + lane + 64 * j);
    }
    weight_items(p, scr, lane, gw, NGW, 0, LATE_W ? W_P1 : W_ALL);
#pragma unroll
    for (int j = 0; j < 16; ++j) { const int i = tid + j * NTHR, k = i >> 3, c = i & 7; wfT[c * 1024 + k] = wfv[j]; }
    __syncthreads();
    {
        bf16_t* hn = (bf16_t*)(ws + WS_HN); float* logf = (float*)(ws + WS_LOGF);
        for (int m = gw; m < MROWS; m += NGW) {
            f32x4 v[4]; float s = 0.f;
#pragma unroll
            for (int j = 0; j < 4; ++j) { v[j] = vn[j]; vn[j] = vn2[j]; s += (v[j][0] * v[j][0] + v[j][1] * v[j][1]) + (v[j][2] * v[j][2] + v[j][3] * v[j][3]); }
            if (m + 2 * NGW < MROWS) {
#pragma unroll
                for (int j = 0; j < 4; ++j) vn2[j] = __builtin_nontemporal_load((const f32x4*)(x + (size_t)(m + 2 * NGW) * DM) + lane + 64 * j);
            }
            const float rs = rsqrtf(wave_sum(s) * (1.0f / 1024.0f) + EPS);
            float ff[8];
#pragma unroll
            for (int c = 0; c < 8; ++c) { float a = 0.f;
#pragma unroll
                for (int j = 0; j < 4; ++j) { const f32x4 w = *(const LAS f32x4*)(wfT + c * 1024 + 256 * j + 4 * lane); a += (v[j][0] * w[0] + v[j][1] * w[1]) + (v[j][2] * w[2] + v[j][3] * w[3]); }
                ff[c] = wave_sum(a) * rs; }
            unsigned long long* o8 = (unsigned long long*)(hn + (size_t)m * DM) + lane;
#pragma unroll
            for (int j = 0; j < 4; ++j) { const f32x4 y = v[j] * gm[j] * rs; o8[64 * j] = (unsigned long long)pkbf(y[0], y[1]) | ((unsigned long long)pkbf(y[2], y[3]) << 32); }
            if (lane < 8) { float z = 0.f;
#pragma unroll
                for (int c = 0; c < 8; ++c) if (lane == c) z = ff[c];
                z += b_forget[lane];
                logf[(size_t)m * 8 + lane] = fminf(z, 0.f) - log1pf(__expf(-fabsf(z))); }
        }
#pragma unroll
        for (int j = 0; j < 4; ++j) gm[j] = ((const f32x4*)g_mem)[lane + 64 * j];
        bf16_t* memn = (bf16_t*)(ws + WS_MEMN);
        for (int m = gw; m < MEMROWS; m += NGW) {
            const f32x4* xr = (const f32x4*)(mem + (size_t)m * DM) + lane;
            f32x4 v[4]; float s = 0.f;
#pragma unroll
            for (int j = 0; j < 4; ++j) { v[j] = (m == gw) ? mv[j] : xr[64 * j]; s += (v[j][0] * v[j][0] + v[j][1] * v[j][1]) + (v[j][2] * v[j][2] + v[j][3] * v[j][3]); }
            const float rs = rsqrtf(wave_sum(s) * (1.0f / 1024.0f) + EPS);
            unsigned long long* o8 = (unsigned long long*)(memn + (size_t)m * DM) + lane;
#pragma unroll
            for (int j = 0; j < 4; ++j) { const f32x4 y = v[j] * gm[j] * rs; o8[64 * j] = (unsigned long long)pkbf(y[0], y[1]) | ((unsigned long long)pkbf(y[2], y[3]) << 32); }
        }
    }
    {
        float* cs = (float*)(ws + WS_COS); float* sn = (float*)(ws + WS_SIN);
        for (int e = vcu * NTHR + tid; e < SEQ * 32; e += G * NTHR) {
            const int t = e >> 5, i = e & 31;
            double invf = 1.0; for (int k = 0; k < i; ++k) invf *= 0.74989420933245582730;
            const double rev = (double)t * invf * 0.15915494309189533577;
            const float fr = (float)(rev - __builtin_rint(rev));
            cs[e] = __builtin_amdgcn_cosf(fr); sn[e] = __builtin_amdgcn_sinf(fr);
        }
    }
}

__device__ __forceinline__ void fox_cumsum(const Params& p, ldsp_t lds, int bh) {
    const int tid = threadIdx.x; const int b = bh >> 3, h = bh & 7;
    const float* logf = (const float*)(p.ws + WS_LOGF) + ((size_t)b * SEQ) * 8 + h; float* Fc = (float*)(p.ws + WS_FC) + (size_t)bh * SEQ;
    LAS double* part = (LAS double*)lds;
    double loc[8]; double run = 0.0;
#pragma unroll
    for (int i = 0; i < 8; ++i) { run += (double)logf[(size_t)(tid * 8 + i) * 8]; loc[i] = run; }
    part[tid] = run; __syncthreads();
    for (int o = 1; o < NTHR; o <<= 1) { double v = (tid >= o) ? part[tid - o] : 0.0; __syncthreads(); part[tid] += v; __syncthreads(); }
    const double base = (tid > 0) ? part[tid - 1] : 0.0;
#pragma unroll
    for (int i = 0; i < 8; ++i) Fc[tid * 8 + i] = (float)((base + loc[i]) * 1.4426950408889634);
    __syncthreads();
}

__device__ __forceinline__ void ret_kv_unit(const Params& p, ldsp_t lds, int u) {
    const int tid = threadIdx.x, lane = tid & 63, wid = __builtin_amdgcn_readfirstlane(tid >> 6), r32 = lane & 31, hi = lane >> 5;
    const int bh = u >> 5, cp = u & 31, b = bh >> 3, h = bh & 7;
    const bf16_t* P = (const bf16_t*)(p.ws + WS_P); float* kvT = (float*)(p.ws + WS_KVT);
    const float lg = log2f(1.0f - exp2f(-5.0f - (float)h));
    {
        const int ch = tid >> 8, t = tid & 255, row = t >> 2, c0 = (t & 3) * 16;
        const size_t grow = (size_t)b * SEQ + (size_t)(2 * cp + ch) * 64 + row;
        const bf16_t* kp = P + grow * PP + C_RK + h * 64 + c0; const bf16_t* vp = P + grow * PP + C_RV + h * 64 + c0;
        u32x4 k0 = *(const u32x4*)kp, k1 = *(const u32x4*)(kp + 8), v0 = *(const u32x4*)vp, v1 = *(const u32x4*)(vp + 8);
        const float dec = exp2f(lg * (float)(63 - row));
        u32x4 d0, d1;
        d0.x = pkbf(bflo(k0.x) * dec, bfhi(k0.x) * dec); d0.y = pkbf(bflo(k0.y) * dec, bfhi(k0.y) * dec); d0.z = pkbf(bflo(k0.z) * dec, bfhi(k0.z) * dec); d0.w = pkbf(bflo(k0.w) * dec, bfhi(k0.w) * dec);
        d1.x = pkbf(bflo(k1.x) * dec, bfhi(k1.x) * dec); d1.y = pkbf(bflo(k1.y) * dec, bfhi(k1.y) * dec); d1.z = pkbf(bflo(k1.z) * dec, bfhi(k1.z) * dec); d1.w = pkbf(bflo(k1.w) * dec, bfhi(k1.w) * dec);
        ldsp_t kl = lds + ch * 18432 + row * 144 + c0 * 2; ldsp_t vl = kl + 9216;
        *(LAS u32x4*)kl = d0; *(LAS u32x4*)(kl + 16) = d1; *(LAS u32x4*)vl = v0; *(LAS u32x4*)(vl + 16) = v1;
    }
    __syncthreads();
    {
        const int ch = wid >> 2, eb = (wid >> 1) & 1, db = wid & 1;
        ldsp_t kl = lds + ch * 18432, vl = kl + 9216;
        const int q = (lane & 15) >> 2, pq = lane & 3, g1 = (lane >> 4) & 1;
        f32x16 acc = {};
#pragma unroll
        for (int s = 0; s < 4; ++s) {
            const int r0 = 16 * s + 8 * hi + q;
            const bf16x8 a = cat8(tr_rd(vl + r0 * 144 + (32 * eb + 16 * g1 + 4 * pq) * 2), tr_rd(vl + (r0 + 4) * 144 + (32 * eb + 16 * g1 + 4 * pq) * 2));
            const bf16x8 bb = cat8(tr_rd(kl + r0 * 144 + (32 * db + 16 * g1 + 4 * pq) * 2), tr_rd(kl + (r0 + 4) * 144 + (32 * db + 16 * g1 + 4 * pq) * 2));
            acc = MFMA32(a, bb, acc);
        }
        float* op = kvT + ((size_t)bh * 64 + 2 * cp + ch) * 4096;
#pragma unroll
        for (int r = 0; r < 16; ++r) op[(32 * eb + crow(r, hi)) * 64 + 32 * db + r32] = acc[r];
    }
    __syncthreads();
}

__device__ __forceinline__ void knorm_pass(const Params& p, int vcu, int G) {
    const int lane = threadIdx.x & 63, wave = __builtin_amdgcn_readfirstlane((int)threadIdx.x >> 6);
    bf16_t* KV = (bf16_t*)(p.ws + WS_KVM); const float* kss = (const float*)(p.ws + WS_KSS);
    for (int it = vcu * NWAVES + wave; it < MEMROWS * 4; it += G * NWAVES) {
        const int row = it >> 2, hd = it & 3;
        const f32x4 kv4 = *(const f32x4*)(kss + (size_t)row * 16 + hd * 4);
        const float ks = rsqrtf(((kv4[0] + kv4[1]) + (kv4[2] + kv4[3])) * (1.0f / 256.0f) + EPS);
        u32x2* ptr = (u32x2*)(KV + (size_t)row * 2048 + hd * 256 + lane * 4);
        const u32x2 w = *ptr; u32x2 o; o.x = pkbf(bflo(w.x) * ks, bfhi(w.x) * ks); o.y = pkbf(bflo(w.y) * ks, bfhi(w.y) * ks); *ptr = o;
    }
}

__device__ __forceinline__ void ret_out_unit8(const Params& p, ldsp_t lds, int u) {
    const int tid = threadIdx.x, lane = tid & 63, wid = __builtin_amdgcn_readfirstlane(tid >> 6), r32 = lane & 31, hi = lane >> 5;
    const int bh = u >> 3, g8 = u & 7, b = bh >> 3, h = bh & 7, c0 = 8 * g8;
    const bf16_t* P = (const bf16_t*)(p.ws + WS_P); const float* kvT = (const float*)(p.ws + WS_KVT); bf16_t* mix = (bf16_t*)(p.ws + WS_HN);
    const float* g_ret = p.in[5] + h * 64;
    const float lg = log2f(1.0f - exp2f(-5.0f - (float)h));
    {
        const float cd = exp2f(64.0f * lg);
        const float* src = kvT + (size_t)bh * 64 * 4096 + tid * 8;
        f32x4 sa = {0.f, 0.f, 0.f, 0.f}, sb = {0.f, 0.f, 0.f, 0.f};
        int cb = 0;
        for (; cb + 16 <= c0; cb += 16) {
            f32x4 v[16][2];
#pragma unroll
            for (int j = 0; j < 16; ++j) { v[j][0] = *(const f32x4*)(src + (size_t)(cb + j) * 4096); v[j][1] = *(const f32x4*)(src + (size_t)(cb + j) * 4096 + 4); }
#pragma unroll
            for (int j = 0; j < 16; ++j) { sa = sa * cd + v[j][0]; sb = sb * cd + v[j][1]; }
        }
        if (cb < c0) {
            f32x4 v[8][2];
#pragma unroll
            for (int j = 0; j < 8; ++j) { v[j][0] = *(const f32x4*)(src + (size_t)(cb + j) * 4096); v[j][1] = *(const f32x4*)(src + (size_t)(cb + j) * 4096 + 4); }
#pragma unroll
            for (int j = 0; j < 8; ++j) { sa = sa * cd + v[j][0]; sb = sb * cd + v[j][1]; }
        }
        f32x4 own[8][2];
#pragma unroll
        for (int j = 0; j < 8; ++j) { own[j][0] = *(const f32x4*)(src + (size_t)(c0 + j) * 4096); own[j][1] = *(const f32x4*)(src + (size_t)(c0 + j) * 4096 + 4); }
        ldsp_t sl = lds + 36864 + (tid >> 3) * 144 + (tid & 7) * 16;
#pragma unroll
        for (int j = 0; j < 8; ++j) {
            u32x4 w; w.x = pkbf(sa[0], sa[1]); w.y = pkbf(sa[2], sa[3]); w.z = pkbf(sb[0], sb[1]); w.w = pkbf(sb[2], sb[3]);
            *(LAS u32x4*)(sl + j * 9216) = w;
            sa = sa * cd + own[j][0]; sb = sb * cd + own[j][1];
        }
    }
#pragma unroll 1
    for (int bt = 0; bt < 2; ++bt) {
        {
            const int ch = tid >> 7, t = tid & 127, row = t >> 1, cc0 = (t & 1) * 32;
            const bf16_t* vp = P + ((size_t)b * SEQ + (size_t)(c0 + 4 * bt + ch) * 64 + row) * PP + C_RV + h * 64 + cc0;
            ldsp_t vl = lds + ch * 9216 + row * 144 + cc0 * 2;
#pragma unroll
            for (int i = 0; i < 4; ++i) *(LAS u32x4*)(vl + 16 * i) = *(const u32x4*)(vp + 8 * i);
        }
        const int ch = wid >> 1, ih = wid & 1, c = c0 + 4 * bt + ch;
        const size_t crow0 = (size_t)b * SEQ + (size_t)c * 64;
        const int i_tok = 32 * ih + r32; const size_t row_i = crow0 + i_tok;
        bf16x8 qf[4], kf0[4], kf1[4];
#pragma unroll
        for (int s = 0; s < 4; ++s) { qf[s] = *(const bf16x8*)(P + row_i * PP + C_RQ + h * 64 + 16 * s + 8 * hi);
            kf0[s] = *(const bf16x8*)(P + (crow0 + r32) * PP + C_RK + h * 64 + 16 * s + 8 * hi);
            kf1[s] = *(const bf16x8*)(P + (crow0 + 32 + r32) * PP + C_RK + h * 64 + 16 * s + 8 * hi); }
        __syncthreads();
        f32x16 st0 = {}, st1 = {};
#pragma unroll
        for (int s = 0; s < 4; ++s) { st0 = MFMA32(kf0[s], qf[s], st0); st1 = MFMA32(kf1[s], qf[s], st1); }
#pragma unroll
        for (int r = 0; r < 16; ++r) { const int j0 = crow(r, hi), j1 = 32 + j0;
            st0[r] *= 0.125f * exp2f(lg * fabsf((float)(i_tok - j0))); st1[r] *= 0.125f * exp2f(lg * fabsf((float)(i_tok - j1))); }
        bf16x8 pf[4]; pf[0] = pack8(st0, 0); pf[1] = pack8(st0, 1); pf[2] = pack8(st1, 0); pf[3] = pack8(st1, 1);
        ldsp_t vl = lds + ch * 9216; ldsp_t sl = lds + 36864 + (4 * bt + ch) * 9216;
        const int q = (lane & 15) >> 2, pq = lane & 3, g1 = (lane >> 4) & 1;
        f32x16 o0 = {}, o1 = {}, t0 = {}, t1 = {};
#pragma unroll
        for (int s = 0; s < 4; ++s) {
            const int r0 = 16 * s + 4 * hi + q;
            const bf16x8 a0 = cat8(tr_rd(vl + r0 * 144 + (16 * g1 + 4 * pq) * 2), tr_rd(vl + (r0 + 8) * 144 + (16 * g1 + 4 * pq) * 2));
            const bf16x8 a1 = cat8(tr_rd(vl + r0 * 144 + (32 + 16 * g1 + 4 * pq) * 2), tr_rd(vl + (r0 + 8) * 144 + (32 + 16 * g1 + 4 * pq) * 2));
            o0 = MFMA32(a0, pf[s], o0); o1 = MFMA32(a1, pf[s], o1);
            const bf16x8 s0 = *(const LAS bf16x8*)(sl + r32 * 144 + (16 * s + 8 * hi) * 2);
            const bf16x8 s1 = *(const LAS bf16x8*)(sl + (32 + r32) * 144 + (16 * s + 8 * hi) * 2);
            t0 = MFMA32(s0, qf[s], t0); t1 = MFMA32(s1, qf[s], t1);
        }
        const float qd = 0.125f * exp2f(lg * (float)(i_tok + 1));
        float sum = 0.f;
#pragma unroll
        for (int r = 0; r < 16; ++r) { o0[r] += qd * t0[r]; o1[r] += qd * t1[r]; sum += o0[r] + o1[r]; }
        sum += __shfl_xor(sum, 32); const float mu = sum * (1.0f / 64.0f);
        float var = 0.f;
#pragma unroll
        for (int r = 0; r < 16; ++r) { o0[r] -= mu; o1[r] -= mu; var += o0[r] * o0[r] + o1[r] * o1[r]; }
        var += __shfl_xor(var, 32); const float rstd = rsqrtf(var * (1.0f / 64.0f) + EPS);
        const bf16_t* gp = P + row_i * PP + C_RG + h * 64; bf16_t* mp = mix + row_i * DM + h * 64;
#pragma unroll
        for (int eb = 0; eb < 2; ++eb)
#pragma unroll
            for (int g = 0; g < 4; ++g) {
                const int e0 = 32 * eb + 8 * g + 4 * hi;
                const u32x2 gw = *(const u32x2*)(gp + e0); const f32x4 gr = *(const f32x4*)(g_ret + e0);
                const float gt[4] = {bflo(gw.x), bfhi(gw.x), bflo(gw.y), bfhi(gw.y)}; float y[4];
#pragma unroll
                for (int e = 0; e < 4; ++e) { const float v = (eb ? o1[4 * g + e] : o0[4 * g + e]) * rstd * gr[e]; const float z = gt[e];
                    y[e] = v * z * __builtin_amdgcn_rcpf(1.0f + __builtin_amdgcn_exp2f(-z * LOG2E)); }
                u32x2 w; w.x = pkbf(y[0], y[1]); w.y = pkbf(y[2], y[3]); st8(mp + e0, w);
            }
        __syncthreads();
    }
}

__device__ __forceinline__ void fox_unit(const Params& p, ldsp_t lds, int bh, int qb, float thr) {
    const int tid = threadIdx.x, lane = tid & 63, wid = __builtin_amdgcn_readfirstlane(tid >> 6), r32 = lane & 31, hi = lane >> 5;
    const int b = bh >> 3, h = bh & 7; const size_t rowbase = (size_t)b * SEQ; const int t0 = qb * 256;
    const bf16_t* P = (const bf16_t*)(p.ws + WS_P); bf16_t* mix = (bf16_t*)(p.ws + WS_HN);
    const bf16_t* Kg = P + rowbase * PP + C_FK + h * 64; const bf16_t* Vg = P + rowbase * PP + C_FV + h * 64;
    const float* Fg = (const float*)(p.ws + WS_FC) + (size_t)bh * SEQ;
    const int NT = 2 * qb + 2;
    const size_t qrow = rowbase + t0 + wid * 32 + r32;
    const int srow = tid >> 3, sch = tid & 7;
    bf16x8 qr[4];
#pragma unroll
    for (int s = 0; s < 4; ++s) qr[s] = *(const bf16x8*)(P + qrow * PP + C_FQ + h * 64 + 16 * s + 8 * hi);
    u32x4 kreg0, kreg1, vreg0, vreg1; float freg = 0.f;
    { const size_t r = (size_t)(NT - 1) * 128 + srow;
      kreg0 = *(const u32x4*)(Kg + r * PP + sch * 8); kreg1 = *(const u32x4*)(Kg + (r + 64) * PP + sch * 8);
      vreg0 = *(const u32x4*)(Vg + r * PP + sch * 8); vreg1 = *(const u32x4*)(Vg + (r + 64) * PP + sch * 8); }
    const float fref = Fg[t0];
    const float fl = Fg[128 * (lane < NT ? lane : 0) + 127];
    const float ft = (tid < 128) ? Fg[(NT - 1) * 128 + tid] : 0.f;
    if (tid < 128) freg = fref - ft;
    int tk0;
    { const bool ok = (lane < NT) && ((fref - fl) >= -thr);
      const unsigned long long mk = __ballot(ok); tk0 = mk ? (int)__builtin_ctzll(mk) : (NT - 2); if (tk0 > NT - 2) tk0 = NT - 2;
      tk0 = __builtin_amdgcn_readfirstlane(tk0); }
    *(LAS u32x4*)(lds + srow * 144 + sch * 16) = kreg0; *(LAS u32x4*)(lds + (srow + 64) * 144 + sch * 16) = kreg1;
    *(LAS u32x4*)(lds + 36864 + srow * 144 + sch * 16) = vreg0; *(LAS u32x4*)(lds + 36864 + (srow + 64) * 144 + sch * 16) = vreg1;
    if (tid < 128) *(LAS float*)(lds + 73728 + tid * 4) = freg;
    __syncthreads();
    f32x16 o0 = {}, o1 = {}; float mrun = -INFINITY, lrun = 0.f;
    const int qrel = wid * 32 + r32;
    const int q = (lane & 15) >> 2, pq = lane & 3, g1 = (lane >> 4) & 1;
    int buf = 0;
    for (int tk = NT - 1; tk >= tk0; --tk) {
        const bool more = (tk > tk0);
        if (more) { const size_t r = (size_t)(tk - 1) * 128 + srow;
            kreg0 = *(const u32x4*)(Kg + r * PP + sch * 8); kreg1 = *(const u32x4*)(Kg + (r + 64) * PP + sch * 8);
            vreg0 = *(const u32x4*)(Vg + r * PP + sch * 8); vreg1 = *(const u32x4*)(Vg + (r + 64) * PP + sch * 8);
            if (tid < 128) freg = fref - Fg[(tk - 1) * 128 + tid]; }
        const int jb = tk - (NT - 2);
        if (!(jb >= 0 && 128 * jb > wid * 32 + 31)) {
            ldsp_t kl = lds + buf * 18432, vl = lds + 36864 + buf * 18432; const LAS float* nb = (const LAS float*)(lds + 73728 + buf * 512);
            f32x16 pb[4];
#pragma unroll
            for (int blk = 0; blk < 4; ++blk)
#pragma unroll
                for (int g = 0; g < 4; ++g) { const f32x4 n0 = *(const LAS f32x4*)(nb + 32 * blk + 8 * g + 4 * hi);
#pragma unroll
                    for (int e = 0; e < 4; ++e) pb[blk][4 * g + e] = n0[e]; }
#pragma unroll
            for (int s = 0; s < 4; ++s)
#pragma unroll
                for (int blk = 0; blk < 4; ++blk) {
                    const bf16x8 kf = *(const LAS bf16x8*)(kl + (32 * blk + r32) * 144 + (16 * s + 8 * hi) * 2);
                    pb[blk] = MFMA32(kf, qr[s], pb[blk]);
                }
            if (jb >= 0) {
#pragma unroll
                for (int blk = 0; blk < 4; ++blk)
#pragma unroll
                    for (int r = 0; r < 16; ++r) { const int kv = 128 * jb + 32 * blk + crow(r, hi); if (kv > qrel) pb[blk][r] = -INFINITY; }
            }
            float bm[4];
#pragma unroll
            for (int blk = 0; blk < 4; ++blk) { float m4 = pb[blk][0];
#pragma unroll
                for (int r = 1; r < 16; r += 2) m4 = fmaxf(m4, fmaxf(pb[blk][r], pb[blk][r < 15 ? r + 1 : r])); bm[blk] = m4; }
            float mx = fmaxf(fmaxf(bm[0], bm[1]), fmaxf(bm[2], bm[3]));
            mx = fmaxf(mx, __shfl_xor(mx, 32));
            const float mnew = fmaxf(mrun, mx);
            if (__any(mnew != mrun)) {
                const float sc = __builtin_amdgcn_exp2f(mrun - mnew); lrun *= sc;
#pragma unroll
                for (int r = 0; r < 16; ++r) { o0[r] *= sc; o1[r] *= sc; }
            }
            mrun = mnew;
            float rsum = 0.f;
#pragma unroll
            for (int blk = 0; blk < 4; ++blk) {
                if (__all(bm[blk] < mnew - 40.0f)) continue;
#pragma unroll
                for (int r = 0; r < 16; ++r) { pb[blk][r] = __builtin_amdgcn_exp2f(pb[blk][r] - mnew); rsum += pb[blk][r]; }
#pragma unroll
                for (int hf = 0; hf < 2; ++hf) {
                    const int s = 2 * blk + hf;
                    const bf16x8 pf = pack8(pb[blk], hf);
                    const int r0 = 16 * s + 4 * hi + q;
                    const bf16x8 a0 = cat8(tr_rd(vl + r0 * 144 + (16 * g1 + 4 * pq) * 2), tr_rd(vl + (r0 + 8) * 144 + (16 * g1 + 4 * pq) * 2));
                    const bf16x8 a1 = cat8(tr_rd(vl + r0 * 144 + (32 + 16 * g1 + 4 * pq) * 2), tr_rd(vl + (r0 + 8) * 144 + (32 + 16 * g1 + 4 * pq) * 2));
                    o0 = MFMA32(a0, pf, o0); o1 = MFMA32(a1, pf, o1);
                }
            }
            lrun += rsum;
        }
        if (more) { const int nbuf = buf ^ 1;
            *(LAS u32x4*)(lds + nbuf * 18432 + srow * 144 + sch * 16) = kreg0; *(LAS u32x4*)(lds + nbuf * 18432 + (srow + 64) * 144 + sch * 16) = kreg1;
            *(LAS u32x4*)(lds + 36864 + nbuf * 18432 + srow * 144 + sch * 16) = vreg0; *(LAS u32x4*)(lds + 36864 + nbuf * 18432 + (srow + 64) * 144 + sch * 16) = vreg1;
            if (tid < 128) *(LAS float*)(lds + 73728 + nbuf * 512 + tid * 4) = freg; }
        __syncthreads();
        buf ^= 1;
    }
    lrun += __shfl_xor(lrun, 32);
    const float inv = 1.0f / lrun;
    bf16_t* mp = mix + qrow * DM + 512 + h * 64;
#pragma unroll
    for (int g = 0; g < 4; ++g) {
        u32x2 w0, w1; w0.x = pkbf(o0[4 * g] * inv, o0[4 * g + 1] * inv); w0.y = pkbf(o0[4 * g + 2] * inv, o0[4 * g + 3] * inv);
        w1.x = pkbf(o1[4 * g] * inv, o1[4 * g + 1] * inv); w1.y = pkbf(o1[4 * g + 2] * inv, o1[4 * g + 3] * inv);
        st8(mp + 8 * g + 4 * hi, w0); st8(mp + 32 + 8 * g + 4 * hi, w1);
    }
}
__device__ __forceinline__ void fox_phase(const Params& p, ldsp_t lds) {
    const int tid = threadIdx.x, lane = tid & 63;
    float amax = fabsf(p.in[6][lane]), bmax = fabsf(p.in[7][lane]);
#pragma unroll
    for (int o = 1; o < 64; o <<= 1) { amax = fmaxf(amax, __shfl_xor(amax, o)); bmax = fmaxf(bmax, __shfl_xor(bmax, o)); }
    const float thr = 2.0f * (8.0f * amax * bmax * LOG2E) + 40.0f;
    volatile LAS int* qw = (volatile LAS int*)(lds + 147200 + 128);
    unsigned* ctr = (unsigned*)p.ws + 3584;
    for (;;) {
        if (tid == 0) *qw = (int)atomicAdd(ctr, 1u);
        __syncthreads();
        const int idx = *qw;
        __syncthreads();
        if (idx >= 512 + 1024) break;
        if (idx < 512) fox_unit(p, lds, idx & 31, 15 - (idx >> 5), thr);
        else ret_kv_unit(p, lds, idx - 512);
    }
}

__device__ __forceinline__ void xattn_unit(const Params& p, ldsp_t lds, int u) {
    const int tid = threadIdx.x, lane = tid & 63, wid = __builtin_amdgcn_readfirstlane(tid >> 6), r32 = lane & 31, hi = lane >> 5;
    const int b = u >> 6, qblk = (u & 63) >> 2, hd = u & 3;
    const bf16_t* qx = (const bf16_t*)(p.ws + WS_QX); const bf16_t* KV = (const bf16_t*)(p.ws + WS_KVM); bf16_t* ob = (bf16_t*)(p.ws + WS_O);
    const float* ss1 = (const float*)(p.ws + WS_SS1); const float* qss = (const float*)(p.ws + WS_QSS); const float* kss = (const float*)(p.ws + WS_KSS);
    const size_t R = (size_t)b * SEQ + qblk * 256 + wid * 32 + r32;
    const int srow = tid >> 3, spart = tid & 7;
    const bf16_t* kvbase = KV + ((size_t)b * NMEM + srow) * 2048 + hd * 256 + spart * 32;
    {
        u32x4 kr[4][4];
#pragma unroll
        for (int ps = 0; ps < 4; ++ps)
#pragma unroll
            for (int i = 0; i < 4; ++i) kr[ps][i] = *(const u32x4*)(kvbase + (size_t)ps * 64 * 2048 + 8 * i);
#pragma unroll
        for (int ps = 0; ps < 4; ++ps)
#pragma unroll
            for (int i = 0; i < 4; ++i) *(LAS u32x4*)(lds + (ps * 64 + srow) * 560 + spart * 64 + 16 * i) = kr[ps][i];
    }
    float qscale;
    { const f32x4* sp = (const f32x4*)(ss1 + R * 16); const f32x4 a = sp[0], bq = sp[1], c = sp[2], d = sp[3];
      const float tot = ((a[0] + a[1]) + (a[2] + a[3])) + ((bq[0] + bq[1]) + (bq[2] + bq[3])) + ((c[0] + c[1]) + (c[2] + c[3])) + ((d[0] + d[1]) + (d[2] + d[3]));
      const float r1 = rsqrtf(tot * (1.0f / 1024.0f) + EPS);
      const f32x4 qv = *(const f32x4*)(qss + R * 16 + hd * 4); const float qs = (qv[0] + qv[1]) + (qv[2] + qv[3]);
      qscale = r1 * rsqrtf(r1 * r1 * qs * (1.0f / 256.0f) + EPS) * (0.0625f * LOG2E); }
    const bf16_t* qp = qx + R * DM + hd * 256 + 8 * hi;
    __syncthreads();
    f32x16 S[8];
#pragma unroll
    for (int i = 0; i < 8; ++i) S[i] = (f32x16){};
#pragma unroll 8
    for (int s = 0; s < 16; ++s) {
        const bf16x8 qf = *(const bf16x8*)(qp + 16 * s);
#pragma unroll
        for (int blk = 0; blk < 8; ++blk) {
            const bf16x8 kf = *(const LAS bf16x8*)(lds + (32 * blk + r32) * 560 + (16 * s + 8 * hi) * 2);
            S[blk] = MFMA32(kf, qf, S[blk]);
        }
    }
    float mx = -INFINITY;
#pragma unroll
    for (int blk = 0; blk < 8; ++blk)
#pragma unroll
        for (int r = 0; r < 16; ++r) mx = fmaxf(mx, S[blk][r]);
    mx *= qscale;
    mx = fmaxf(mx, __shfl_xor(mx, 32));
    float lsum = 0.f;
    bf16x8 pf[16];
#pragma unroll
    for (int blk = 0; blk < 8; ++blk) {
        f32x16 e;
#pragma unroll
        for (int r = 0; r < 16; ++r) { e[r] = __builtin_amdgcn_exp2f(S[blk][r] * qscale - mx); lsum += e[r]; }
        pf[2 * blk] = pack8(e, 0); pf[2 * blk + 1] = pack8(e, 1);
        asm volatile("" : "+v"(pf[2 * blk]), "+v"(pf[2 * blk + 1]));
    }
    lsum += __shfl_xor(lsum, 32);
    const float inv = 1.0f / lsum;
    __syncthreads();
    const bf16_t* vbase = kvbase + 1024;
#pragma unroll
    for (int hp = 0; hp < 2; ++hp) {
        u32x4 vr[2][4];
#pragma unroll
        for (int ps = 0; ps < 2; ++ps)
#pragma unroll
            for (int i = 0; i < 4; ++i) vr[ps][i] = *(const u32x4*)(vbase + (size_t)(2 * hp + ps) * 64 * 2048 + 8 * i);
#pragma unroll
        for (int ps = 0; ps < 2; ++ps)
#pragma unroll
            for (int i = 0; i < 4; ++i) *(LAS u32x4*)(lds + ((2 * hp + ps) * 64 + srow) * 560 + spart * 64 + 16 * i) = vr[ps][i];
        asm volatile("" ::: "memory");
    }
    __syncthreads();
    const int q = (lane & 15) >> 2, pq = lane & 3, g1 = (lane >> 4) & 1;
    bf16_t* op = ob + R * DM + hd * 256;
#pragma unroll
    for (int blk = 0; blk < 8; ++blk) {
        f32x16 o = {};
#pragma unroll
        for (int s = 0; s < 16; ++s) {
            const int r0 = 16 * s + 4 * hi + q;
            const bf16x8 a = cat8(tr_rd(lds + r0 * 560 + (32 * blk + 16 * g1 + 4 * pq) * 2), tr_rd(lds + (r0 + 8) * 560 + (32 * blk + 16 * g1 + 4 * pq) * 2));
            o = MFMA32(a, pf[s], o);
        }
#pragma unroll
        for (int g = 0; g < 4; ++g) {
            u32x2 w; w.x = pkbf(o[4 * g] * inv, o[4 * g + 1] * inv); w.y = pkbf(o[4 * g + 2] * inv, o[4 * g + 3] * inv);
            st8(op + 32 * blk + 8 * g + 4 * hi, w);
        }
    }
    __syncthreads();
}

__global__ void __launch_bounds__(NTHR, 2) hymba_fwd(Params p, int ph_lo, int ph_hi, int coop) {
    extern __shared__ __attribute__((aligned(16))) unsigned char lds_raw[];
    ldsp_t lds = (ldsp_t)lds_raw;
    const int G = gridDim.x, bx = blockIdx.x;
    const int vcu = (G % 8 == 0) ? (bx % 8) * (G / 8) + bx / 8 : bx;
    unsigned char* ws = p.ws;
    bf16_t* HN = (bf16_t*)(ws + WS_HN); bf16_t* PB = (bf16_t*)(ws + WS_P);
    if (threadIdx.x < 64) ((LAS unsigned*)(lds + 147200))[threadIdx.x] = 0u;
    __syncthreads();
    XcdBarrier bar = xcd_barrier_post((unsigned*)ws, (volatile LAS unsigned*)(lds + 147200 + 32));
    if (coop == 2) cg::this_grid().sync();
#define IN(k) (ph_lo <= (k) && (k) < ph_hi)
#define SEAM(k) do { if (coop && IN(k) && IN((k) + 1)) xcd_barrier(bar); } while (0)
    if (IN(0)) { p0_prologue(p, lds, vcu, G); __syncthreads(); }
    SEAM(0);
    if (IN(1)) {
        { pg8::Gemm g{HN, (const bf16_t*)(ws + WS_WIN), MROWS, 3584, 1024}; pg8::StaticOrder S; S.init(MROWS, 3584, G, bx);
          pg8::EpiProj E{PB, (const float*)(ws + WS_COS), (const float*)(ws + WS_SIN), p.in[6], p.in[7]};
          pg8::gemm_phase<pg8::EpiProj, pg8::StaticOrder, true, true>(lds, g, S, E); }
        { pg8::Gemm g{(const bf16_t*)(ws + WS_MEMN), (const bf16_t*)(ws + WS_WXKV), MEMROWS, 2048, 1024}; pg8::StaticOrder S; S.init(MEMROWS, 2048, G, (bx + G / 2) % G);
          pg8::EpiKV E{(bf16_t*)(ws + WS_KVM), (float*)(ws + WS_KSS), p.in[13], p.in[14]};
          pg8::gemm_phase<pg8::EpiKV, pg8::StaticOrder, true, true>(lds, g, S, E); }
        __syncthreads();
        if (LATE_W && bx >= 160) { const int wave = __builtin_amdgcn_readfirstlane((int)threadIdx.x >> 6);
            weight_items(p, (LAS float*)(lds + wave * 8448), (int)threadIdx.x & 63, (bx - 160) * NWAVES + wave, 96 * NWAVES, W_EARLY, W_ALL); __syncthreads(); }
        if (G >= 192) { if (bx >= 160 && bx < 192) fox_cumsum(p, lds, bx - 160); }
        else { for (int bh = bx; bh < 32; bh += G) fox_cumsum(p, lds, bh); }
    }
    SEAM(1);
    if (IN(2)) fox_phase(p, lds);
    SEAM(2);
    if (IN(4)) { for (int u = vcu; u < 256; u += G) ret_out_unit8(p, lds, u); knorm_pass(p, vcu, G); }
    SEAM(4);
    if (IN(5)) { pg8::Gemm g{HN, (const bf16_t*)(ws + WS_WOUT), MROWS, 1024, 1024}; pg8::StaticOrder S; S.init(MROWS, 1024, G, bx);
        pg8::EpiRes<false> E{p.in[0], nullptr, (bf16_t*)(ws + WS_H1B), (float*)(ws + WS_SS1)};
        pg8::gemm_phase<pg8::EpiRes<false>, pg8::StaticOrder, true, true>(lds, g, S, E); }
    SEAM(5);
    if (IN(6)) { pg8::Gemm g{(const bf16_t*)(ws + WS_H1B), (const bf16_t*)(ws + WS_WXQ), MROWS, 1024, 1024}; pg8::StaticOrder S; S.init(MROWS, 1024, G, bx);
        pg8::EpiXq E{(bf16_t*)(ws + WS_QX), (float*)(ws + WS_QSS)};
        pg8::gemm_phase<pg8::EpiXq, pg8::StaticOrder, true, true>(lds, g, S, E);
        asm volatile("s_waitcnt vmcnt(0)" ::: "memory");
        __syncthreads();
        if (threadIdx.x == 0) { __builtin_amdgcn_fence(__ATOMIC_ACQUIRE, "agent"); asm volatile("s_waitcnt vmcnt(0)" ::: "memory"); }
        __syncthreads();
        pg8::Unit un;
        for (int i = 0; S.next(i, un); ++i) xattn_unit(p, lds, ((un.pm >> 4) << 6) | ((un.pm & 15) << 2) | un.pn);
    }
    SEAM(6);
    if (IN(8)) { pg8::Gemm g{(const bf16_t*)(ws + WS_O), (const bf16_t*)(ws + WS_WXO), MROWS, 1024, 1024}; pg8::StaticOrder S; S.init(MROWS, 1024, G, bx);
        pg8::EpiRes<true> E{(const void*)(ws + WS_H1B), nullptr, (bf16_t*)(ws + WS_H1B), (float*)(ws + WS_SS2)};
        pg8::gemm_phase<pg8::EpiRes<true>, pg8::StaticOrder, true, true>(lds, g, S, E); }
    SEAM(8);
    if (IN(9)) { pg8::Gemm g{(const bf16_t*)(ws + WS_H1B), (const bf16_t*)(ws + WS_WGU), MROWS, 5632, 1024}; pg8::StaticOrder S; S.init(MROWS, 5632, G, bx);
        const LAS float* rl = nullptr;
        { pg8::Unit u0, ui; bool same = S.next(0, u0);
          for (int i = 1; same && S.next(i, ui); ++i) same = (ui.pm == u0.pm);
          if (same) { LAS float* rt = (LAS float*)(lds + 131072);
              if (threadIdx.x < 256) { const f32x4* sp = (const f32x4*)((const float*)(ws + WS_SS2) + ((size_t)u0.pm * 256 + threadIdx.x) * 16); const f32x4 s0 = sp[0], s1 = sp[1], s2 = sp[2], s3 = sp[3];
                  const float tot = ((s0[0] + s0[1]) + (s0[2] + s0[3])) + ((s1[0] + s1[1]) + (s1[2] + s1[3])) + ((s2[0] + s2[1]) + (s2[2] + s2[3])) + ((s3[0] + s3[1]) + (s3[2] + s3[3]));
                  rt[threadIdx.x] = rsqrtf(tot * (1.0f / 1024.0f) + EPS); }
              __syncthreads(); rl = rt; } }
        pg8::EpiGU E{(bf16_t*)(ws + WS_ACT), (const float*)(ws + WS_SS2), rl};
        pg8::gemm_phase<pg8::EpiGU, pg8::StaticOrder, true, true>(lds, g, S, E);
        if (LATE_W && bx >= 128) { __syncthreads(); const int wave = __builtin_amdgcn_readfirstlane((int)threadIdx.x >> 6);
            weight_items(p, (LAS float*)(lds + wave * 8448), (int)threadIdx.x & 63, (bx - 128) * NWAVES + wave, 128 * NWAVES, W_P1, W_EARLY); __syncthreads(); } }
    SEAM(9);
    if (IN(10)) { pg8::Gemm g{(const bf16_t*)(ws + WS_ACT), (const bf16_t*)(ws + WS_WD), MROWS, 1024, DFF}; pg8::StaticOrder S; S.init(MROWS, 1024, G, bx);
        pg8::EpiRes<true> E{(const void*)(ws + WS_H1B), p.out, nullptr, nullptr};
        pg8::gemm_phase<pg8::EpiRes<true>, pg8::StaticOrder, true, true>(lds, g, S, E); }
#undef IN
#undef SEAM
}

#ifndef N_LAUNCH_MODE
#define N_LAUNCH_MODE 1
#endif
extern "C" void kernel_launch(void* const* d_in, const int* in_sizes, int n_in, void* d_out, int out_size, void* d_ws, size_t ws_size, hipStream_t stream) {
    static int grid = 0;
    if (grid == 0) {
        int dev = 0, cus = 0, per_cu = 0;
        (void)hipGetDevice(&dev); (void)hipDeviceGetAttribute(&cus, hipDeviceAttributeMultiprocessorCount, dev);
        if (hipFuncSetAttribute((const void*)hymba_fwd, hipFuncAttributeMaxDynamicSharedMemorySize, LDS_BYTES) != hipSuccess) fprintf(stderr, "kernel_launch: hipFuncSetAttribute(%d B dynamic LDS) failed\n", LDS_BYTES);
        if (hipOccupancyMaxActiveBlocksPerMultiprocessor(&per_cu, (const void*)hymba_fwd, NTHR, LDS_BYTES) != hipSuccess || per_cu < 1) { fprintf(stderr, "kernel_launch: occupancy query reports %d workgroups per CU\n", per_cu); per_cu = 1; }
        (void)hipGetLastError();
        grid = cus * (per_cu > 1 ? 1 : per_cu);
        if (n_in != 20 || ws_size < WS_END || in_sizes[0] != MROWS * DM || out_size != MROWS * DM) fprintf(stderr, "kernel_launch: unexpected problem (n_in %d, ws %zu)\n", n_in, ws_size);
    }
    Params p{};
    for (int i = 0; i < 20; ++i) p.in[i] = (const float*)d_in[i];
    p.out = (float*)d_out; p.ws = (unsigned char*)d_ws;
    (void)hipMemsetAsync(d_ws, 0, 16384, stream);
    if (N_LAUNCH_MODE == 1) {
        int lo = 0, hi = 11, coop = 1;
        void* args[] = {&p, &lo, &hi, &coop};
        hipError_t e = hipLaunchCooperativeKernel((const void*)hymba_fwd, dim3(grid), dim3(NTHR), args, LDS_BYTES, stream);
        if (e != hipSuccess) fprintf(stderr, "kernel_launch: cooperative launch failed: %s (grid %d)\n", hipGetErrorString(e), grid);
    } else {
        for (int ph = 0; ph < 11; ++ph) hipLaunchKernelGGL(hymba_fwd, dim3(grid), dim3(NTHR), LDS_BYTES, stream, p, ph, ph + 1, 0);
    }
}
```

```cpp
#include <hip/hip_runtime.h>
#include <hip/hip_cooperative_groups.h>
#include <cstdio>
#include <cstdint>
namespace cg = cooperative_groups;
namespace pg8 {
#define PG8_LAS __attribute__((address_space(3)))
typedef unsigned short bf16_t;
typedef short bf16x8 __attribute__((ext_vector_type(8)));
typedef float f32x4 __attribute__((ext_vector_type(4)));
typedef unsigned u32x4 __attribute__((ext_vector_type(4)));
constexpr int BM = 256, BK = 64, HALF = 128, HTB = HALF * BK * 2  , STAGE_BYTES = 8 * HTB, NXCD = 8, WGM = 8;

__host__ __device__ __forceinline__ int lds_byte(int r, int c) { const int st = (r >> 4) * 2 + (c >> 5), rr = r & 15, cc = c & 31, ob = rr * 64 + cc * 2; return st * 1024 + (ob ^ (((ob >> 9) & 1) << 5)); }
__host__ __device__ __forceinline__ void stage_rc(int b, int& R, int& C) { const int st = b / 1024, sb = b % 1024, swz = sb ^ (((sb >> 9) & 1) << 5); R = (st >> 1) * 16 + swz / 64; C = (st & 1) * 32 + (swz % 64) / 2; }
__host__ __device__ __forceinline__ int perm32(int rho) { const int n = rho >> 4, i = rho & 15; return 8 * (i >> 2) + 4 * n + (i & 3); }

struct Unit { int pm, pn; };
struct Gemm { const bf16_t* A; const bf16_t* Bt; int M, N, K; };

struct StaticOrder {
    int nM, nN, nwg, G, c;
    __host__ __device__ void init(int M, int N, int G_, int c_) { nM = M / BM; nN = N / BM; nwg = nM * nN; G = G_; c = c_; }
    __host__ __device__ bool next(int i, Unit& u) const {
        const long L = (long)i * G + c; if (L >= nwg) return false;
        int wgid = (int)L; { const int q = nwg / NXCD, r = nwg % NXCD, xcd = wgid % NXCD, off = wgid / NXCD; wgid = (xcd < r ? xcd * (q + 1) : r * (q + 1) + (xcd - r) * q) + off; }
        const int nig = WGM * nN, gid = wgid / nig, fm = gid * WGM, gsz = (nM - fm) < WGM ? (nM - fm) : WGM;
        u.pm = fm + ((wgid % nig) % gsz); u.pn = (wgid % nig) / gsz; return true;
    }
    __device__ __forceinline__ void a_ready(const Unit&) const {}
    __device__ __forceinline__ void done(const Unit&) const {}
};

__device__ __forceinline__ unsigned cvt_pk_bf16(float lo, float hi) { unsigned r; asm volatile("v_cvt_pk_bf16_f32 %0, %1, %2" : "=v"(r) : "v"(lo), "v"(hi)); return r; }
typedef float f32x2 __attribute__((ext_vector_type(2)));
__device__ __forceinline__ f32x2 gelu_pk(f32x2 v) {
    const f32x2 av = __builtin_elementwise_abs(v), d = av * 0.2316418882f + 1.0f;
    f32x2 t; t.x = __builtin_amdgcn_rcpf(d.x); t.y = __builtin_amdgcn_rcpf(d.y);
    f32x2 q = t * 0.5307027145f + (-0.7265760135f); q = q * t + 0.7107068705f; q = q * t + (-0.142248368f); q = q * t + 0.127414796f; q = q * t;
    const f32x2 s = (v * v) * (-0.72134752044f);
    f32x2 e; e.x = __builtin_amdgcn_exp2f(s.x); e.y = __builtin_amdgcn_exp2f(s.y);
    const f32x2 m = v * (q * e), r = v - m;
    f32x2 o; o.x = v.x < 0.f ? m.x : r.x; o.y = v.y < 0.f ? m.y : r.y; return o;
}

template <int ACT  > struct EpiBf16 {
    static constexpr bool PERM = true, AFTER_DRAIN = false; static_assert(ACT == 0 || ACT == 1, "EpiBf16: ACT is 0 (none) or 1 (gelu_pk)");
    bf16_t* O; int ldc; const float* bias; int split_cols; size_t split_stride; float scale0;
    __device__ __forceinline__ void operator()(const f32x4 (&acc)[2][2][4][2], const Unit& u, int wr, int wc, int fr, int fq) const {
        const int row0 = u.pm * BM + wr * 64 + fr; int colt = u.pn * BM; bf16_t* base = O;
        float sc = 1.f; if (split_cols) { const int t = colt / split_cols; base += (size_t)t * split_stride; colt -= t * split_cols; if (t == 0) sc = scale0; }
        const int col0 = colt + wc * 32 + 8 * fq, bcol0 = u.pn * BM + wc * 32 + 8 * fq;
        f32x4 bv[2][2];
#pragma unroll
        for (int bj = 0; bj < 2; ++bj)
#pragma unroll
            for (int n = 0; n < 2; ++n) bv[bj][n] = bias ? *(const f32x4*)(bias + bcol0 + bj * HALF + 4 * n) : (f32x4){0.f, 0.f, 0.f, 0.f};
#pragma unroll
        for (int ai = 0; ai < 2; ++ai)
#pragma unroll
            for (int m = 0; m < 4; ++m) { bf16_t* rowp = base + (size_t)(row0 + ai * HALF + m * 16) * ldc + col0;
#pragma unroll
                for (int bj = 0; bj < 2; ++bj) { f32x4 v0 = acc[ai][bj][m][0] + bv[bj][0], v1 = acc[ai][bj][m][1] + bv[bj][1];
                    if (ACT == 1) { f32x2 a = gelu_pk((f32x2){v0[0], v0[1]}), b = gelu_pk((f32x2){v0[2], v0[3]}), c = gelu_pk((f32x2){v1[0], v1[1]}), d = gelu_pk((f32x2){v1[2], v1[3]});
                        v0 = (f32x4){a.x, a.y, b.x, b.y}; v1 = (f32x4){c.x, c.y, d.x, d.y}; }
                    v0 = v0 * sc; v1 = v1 * sc; u32x4 w; w.x = cvt_pk_bf16(v0[0], v0[1]); w.y = cvt_pk_bf16(v0[2], v0[3]); w.z = cvt_pk_bf16(v1[0], v1[1]); w.w = cvt_pk_bf16(v1[2], v1[3]);
                    *(u32x4*)(rowp + bj * HALF) = w; } }
    }
};

struct PanelStats {
    unsigned* xbuf;
    unsigned* cnt;
    unsigned* tmo;
    int ntn; float eps;
    unsigned code;
    __device__ __forceinline__ bool run(const f32x4 (&v)[2][2][4][2], const Unit& u, int wr, int wc, int fr, int fq, PG8_LAS unsigned char* lds, int wid, int lane) const {
        typedef float f32x2v __attribute__((ext_vector_type(2)));
        PG8_LAS f32x2v* P = (PG8_LAS f32x2v*)lds;
        PG8_LAS f32x2v* S = (PG8_LAS f32x2v*)(lds + 8192);
        PG8_LAS unsigned* flag = (PG8_LAS unsigned*)(lds + 8192 + 2048);
#pragma unroll
        for (int ai = 0; ai < 2; ++ai)
#pragma unroll
            for (int m = 0; m < 4; ++m) {
                float s = 0.f;
#pragma unroll
                for (int bj = 0; bj < 2; ++bj)
#pragma unroll
                    for (int n = 0; n < 2; ++n) { const f32x4 x = v[ai][bj][m][n]; s += (x[0] + x[1]) + (x[2] + x[3]); }
                s += __shfl_xor(s, 16); s += __shfl_xor(s, 32);
                const float mw = s * (1.0f / 64.0f); float q = 0.f;
#pragma unroll
                for (int bj = 0; bj < 2; ++bj)
#pragma unroll
                    for (int n = 0; n < 2; ++n) { const f32x4 d = v[ai][bj][m][n] - mw; q += (d[0] * d[0] + d[1] * d[1]) + (d[2] * d[2] + d[3] * d[3]); }
                q += __shfl_xor(q, 16); q += __shfl_xor(q, 32);
                if (fq == 0) P[(ai * HALF + wr * 64 + m * 16 + fr) * 4 + wc] = (f32x2v){mw, q};
            }
        asm volatile("s_waitcnt lgkmcnt(0)" ::: "memory"); __builtin_amdgcn_s_barrier(); asm volatile("" ::: "memory");
#if defined(BROKEN_EXCHANGE_NO_WAIT)
#warning BROKEN CONTROL BUILD: the row-statistics exchange does not wait; results are wrong by design
        if (blockIdx.x >= 64) { const long long t0_ = clock64(); while (clock64() - t0_ < 60000) __builtin_amdgcn_s_sleep(8); }
#endif
        const int row = wid * 32 + (lane & 31);
        if (lane < 32) {
            const f32x2v a = P[row * 4 + 0], b = P[row * 4 + 1], c = P[row * 4 + 2], d = P[row * 4 + 3];
            const float mt = (a.x + b.x + c.x + d.x) * 0.25f;
            const float da = a.x - mt, db = b.x - mt, dc = c.x - mt, dd = d.x - mt;
            const float m2 = (a.y + b.y) + (c.y + d.y) + 64.0f * ((da * da + db * db) + (dc * dc + dd * dd));
            unsigned long long* slot = (unsigned long long*)xbuf + ((size_t)(u.pm * BM + row) * 4 + u.pn);
            __hip_atomic_store(slot, ((unsigned long long)__float_as_uint(m2) << 32) | __float_as_uint(mt), __ATOMIC_RELAXED, __HIP_MEMORY_SCOPE_AGENT);
        }
        asm volatile("s_waitcnt vmcnt(0)" ::: "memory");
        if (lane == 0) __hip_atomic_fetch_add(cnt + 64 * u.pm, 1u, __ATOMIC_RELAXED, __HIP_MEMORY_SCOPE_AGENT);
        if (wid == 0) {
            bool dead = false; const unsigned long long t0 = __builtin_amdgcn_s_memrealtime(); const unsigned want = 8u * (unsigned)ntn;
            for (;;) {
#if defined(BROKEN_EXCHANGE_NO_WAIT)
                break;
#endif
                if ((unsigned)__builtin_amdgcn_readfirstlane(__hip_atomic_load(cnt + 64 * u.pm, __ATOMIC_RELAXED, __HIP_MEMORY_SCOPE_AGENT)) >= want) break;
                if (__builtin_amdgcn_s_memrealtime() - t0 > 2000000ull) {
                    if (lane == 0) { unsigned expect = 0u; __hip_atomic_compare_exchange_strong(tmo + 1, &expect, code | (unsigned)(u.pm & 0xff), __ATOMIC_RELAXED, __ATOMIC_RELAXED, __HIP_MEMORY_SCOPE_AGENT);
                                     __hip_atomic_store(tmo, 1u, __ATOMIC_RELAXED, __HIP_MEMORY_SCOPE_AGENT); }
                    dead = true; break; }
                __builtin_amdgcn_s_sleep(2);
            }
            __builtin_amdgcn_fence(__ATOMIC_ACQUIRE, "agent");
            if (lane == 0) flag[0] = dead ? 1u : 0u;
        }
        asm volatile("s_waitcnt vmcnt(0) lgkmcnt(0)" ::: "memory"); __builtin_amdgcn_s_barrier(); asm volatile("" ::: "memory");
        const bool bad = flag[0] != 0u;
        if (lane < 32) {
            const unsigned long long* slot = (const unsigned long long*)xbuf + (size_t)(u.pm * BM + row) * 4; float mt[4], m2[4]; float ms = 0.f;
#pragma unroll
            for (int t = 0; t < 4; ++t) { if (t < ntn) { const unsigned long long w = __hip_atomic_load(slot + t, __ATOMIC_RELAXED, __HIP_MEMORY_SCOPE_AGENT); mt[t] = __uint_as_float((unsigned)w); m2[t] = __uint_as_float((unsigned)(w >> 32)); } else { mt[t] = 0.f; m2[t] = 0.f; } ms += mt[t]; }
            const float mean = ms / (float)ntn; float q = 0.f;
#pragma unroll
            for (int t = 0; t < 4; ++t) if (t < ntn) { const float dm = mt[t] - mean; q += m2[t] + 256.0f * dm * dm; }
            S[row] = (f32x2v){mean, 1.0f / sqrtf(q / (256.0f * (float)ntn) + eps)};
        }
        asm volatile("s_waitcnt lgkmcnt(0)" ::: "memory"); __builtin_amdgcn_s_barrier(); asm volatile("" ::: "memory");
        return bad;
    }
};
struct EpiLnRes {
    static constexpr bool PERM = false, AFTER_DRAIN = true;
    const float* base; float* out; int ldc; const float* bias; PanelStats st; unsigned poison;
    __device__ __forceinline__ void fused(f32x4 (&acc)[2][2][4][2], const Unit& u, int wr, int wc, int fr, int fq, PG8_LAS unsigned char* lds, int wid, int lane) const {
        typedef float f32x2v __attribute__((ext_vector_type(2)));
        const PG8_LAS f32x2v* S = (const PG8_LAS f32x2v*)(lds + 8192);
        const int col0 = u.pn * BM + wc * 32 + 4 * fq;
#pragma unroll
        for (int bj = 0; bj < 2; ++bj)
#pragma unroll
            for (int n = 0; n < 2; ++n) { const f32x4 bv = bias ? *(const f32x4*)(bias + col0 + bj * HALF + n * 16) : (f32x4){0.f, 0.f, 0.f, 0.f};
#pragma unroll
                for (int ai = 0; ai < 2; ++ai)
#pragma unroll
                    for (int m = 0; m < 4; ++m) acc[ai][bj][m][n] += bv; }
        f32x4 pre[4][2][2];
#pragma unroll
        for (int m = 0; m < 4; ++m) { const size_t off = (size_t)(u.pm * BM + wr * 64 + m * 16 + fr) * ldc + col0;
#pragma unroll
            for (int bj = 0; bj < 2; ++bj)
#pragma unroll
                for (int n = 0; n < 2; ++n) pre[m][bj][n] = *(const f32x4*)(base + off + bj * HALF + n * 16); }
        const bool bad = st.run(acc, u, wr, wc, fr, fq, lds, wid, lane) || poison != 0u;
        const float qnan = __builtin_nanf("");
#pragma unroll
        for (int ai = 0; ai < 2; ++ai)
#pragma unroll
            for (int m = 0; m < 4; ++m) { const int r = ai * HALF + wr * 64 + m * 16 + fr; const f32x2v sr = S[r]; const size_t off = (size_t)(u.pm * BM + r) * ldc + col0;
#pragma unroll
                for (int bj = 0; bj < 2; ++bj)
#pragma unroll
                    for (int n = 0; n < 2; ++n) { const f32x4 bs = ai == 0 ? pre[m][bj][n] : *(const f32x4*)(base + off + bj * HALF + n * 16); f32x4 o = bs + (acc[ai][bj][m][n] - sr.x) * sr.y;
                        if (bad) o = (f32x4){qnan, qnan, qnan, qnan}; *(f32x4*)(out + off + bj * HALF + n * 16) = o; }
                if (m & 1) asm volatile("" ::: "memory"); }
    }
};
struct EpiLnResLn {
    static constexpr bool PERM = false, AFTER_DRAIN = true;
    const float* base; float* out; bf16_t* xn; int ldc; const float* bias; PanelStats st1, st2; unsigned poison;
    __device__ __forceinline__ void fused(f32x4 (&acc)[2][2][4][2], const Unit& u, int wr, int wc, int fr, int fq, PG8_LAS unsigned char* lds, int wid, int lane) const {
        typedef float f32x2v __attribute__((ext_vector_type(2))); typedef unsigned u32x2v __attribute__((ext_vector_type(2)));
        const PG8_LAS f32x2v* S = (const PG8_LAS f32x2v*)(lds + 8192);
        const int col0 = u.pn * BM + wc * 32 + 4 * fq;
#pragma unroll
        for (int bj = 0; bj < 2; ++bj)
#pragma unroll
            for (int n = 0; n < 2; ++n) { const f32x4 bv = bias ? *(const f32x4*)(bias + col0 + bj * HALF + n * 16) : (f32x4){0.f, 0.f, 0.f, 0.f};
#pragma unroll
                for (int ai = 0; ai < 2; ++ai)
#pragma unroll
                    for (int m = 0; m < 4; ++m) acc[ai][bj][m][n] += bv; }
        bool bad = st1.run(acc, u, wr, wc, fr, fq, lds, wid, lane) || poison != 0u;
        const float qnan = __builtin_nanf("");
#pragma unroll
        for (int ai = 0; ai < 2; ++ai)
#pragma unroll
            for (int m = 0; m < 4; ++m) { const int r = ai * HALF + wr * 64 + m * 16 + fr; const f32x2v sr = S[r]; const size_t off = (size_t)(u.pm * BM + r) * ldc + col0;
#pragma unroll
                for (int bj = 0; bj < 2; ++bj)
#pragma unroll
                    for (int n = 0; n < 2; ++n) { const f32x4 bs = *(const f32x4*)(base + off + bj * HALF + n * 16); acc[ai][bj][m][n] = bs + (acc[ai][bj][m][n] - sr.x) * sr.y; }
                asm volatile("" : "+v"(acc[ai][0][m][0]), "+v"(acc[ai][0][m][1]), "+v"(acc[ai][1][m][0]), "+v"(acc[ai][1][m][1]));
                if (m & 1) asm volatile("" ::: "memory"); }
        const bool bad1 = bad;
        bad = st2.run(acc, u, wr, wc, fr, fq, lds, wid, lane) || bad;
#pragma unroll
        for (int ai = 0; ai < 2; ++ai)
#pragma unroll
            for (int m = 0; m < 4; ++m) { const int r = ai * HALF + wr * 64 + m * 16 + fr; const f32x2v sr = S[r]; const size_t off = (size_t)(u.pm * BM + r) * ldc + col0;
#pragma unroll
                for (int bj = 0; bj < 2; ++bj)
#pragma unroll
                    for (int n = 0; n < 2; ++n) { const f32x4 x1 = acc[ai][bj][m][n]; *(f32x4*)(out + off + bj * HALF + n * 16) = bad1 ? (f32x4){qnan, qnan, qnan, qnan} : x1;
                        const f32x4 o = (x1 - sr.x) * sr.y; u32x2v w; w.x = cvt_pk_bf16(o[0], o[1]); w.y = cvt_pk_bf16(o[2], o[3]);
                        if (bad) { w.x = 0x7fc07fc0u; w.y = 0x7fc07fc0u; } *(u32x2v*)(xn + off + bj * HALF + n * 16) = w; }
                asm volatile("" ::: "memory"); }
    }
};

template <class Epi, class Sched, bool ALIGN_EPI = false, bool SP2 = false>
__device__ __forceinline__ void gemm_phase(PG8_LAS unsigned char* lds, const Gemm g, const Sched& S, const Epi& E) {
    const int tid = threadIdx.x, wid = __builtin_amdgcn_readfirstlane(tid >> 6), lane = tid & 63, wr = wid >> 2, wc = wid & 3, fr = lane & 15, fq = lane >> 4;
    const int K = g.K, nt = K / BK;
    unsigned voffA[2], voffB[2];
#pragma unroll
    for (int i = 0; i < 2; ++i) { int R, C; stage_rc(tid * 16 + i * 8192, R, C); const int Rb = Epi::PERM ? ((R & ~31) + perm32(R & 31)) : R;
        voffA[i] = (unsigned)(R * K + C) * 2u; voffB[i] = (unsigned)(Rb * K + C) * 2u; }
    const size_t kstep = (size_t)(BK * 2);
    const size_t hstep = (size_t)HALF * K * 2;
    const size_t tstep = 2 * hstep;
    const unsigned ldsw = (unsigned)wid * 1024u;
    const int aoff = lds_byte(wr * 64 + fr, fq * 8), boff = lds_byte(wc * 32 + fr, fq * 8);
#define PG8_SA(b, h) (((b) * 2 + (h)) * HTB)
#define PG8_SB(b, h) ((4 + (b) * 2 + (h)) * HTB)
#define PG8_STAGE(bufoff, gbase, voff) do { _Pragma("unroll") for (int _i = 0; _i < 2; ++_i) \
        __builtin_amdgcn_global_load_lds((const unsigned*)((const char*)(gbase) + (voff)[_i]), (PG8_LAS unsigned*)(lds + (bufoff) + ldsw + _i * 8192), 16, 0, 0); } while (0)
#define PG8_LDA(dst, b, h) do { _Pragma("unroll") for (int m = 0; m < 4; ++m) _Pragma("unroll") for (int k = 0; k < 2; ++k) dst[m][k] = *(const PG8_LAS bf16x8*)(lds + PG8_SA(b, h) + aoff + m * 2048 + k * 1024); } while (0)
#define PG8_LDB(dst, b, h) do { _Pragma("unroll") for (int n = 0; n < 2; ++n) _Pragma("unroll") for (int k = 0; k < 2; ++k) dst[n][k] = *(const PG8_LAS bf16x8*)(lds + PG8_SB(b, h) + boff + n * 2048 + k * 1024); } while (0)
#define PG8_MMA(ai, bj, At, Bt) do { __builtin_amdgcn_s_setprio(1); _Pragma("unroll") for (int m = 0; m < 4; ++m) _Pragma("unroll") for (int n = 0; n < 2; ++n) _Pragma("unroll") for (int k = 0; k < 2; ++k) \
        acc[ai][bj][m][n] = __builtin_amdgcn_mfma_f32_16x16x32_bf16(Bt[n][k], At[m][k], acc[ai][bj][m][n], 0, 0, 0); __builtin_amdgcn_s_setprio(0); } while (0)
#define PG8_WAIT_V(n) asm volatile("s_waitcnt vmcnt(" #n ")" ::: "memory")
#define PG8_WAIT_L(n) asm volatile("s_waitcnt lgkmcnt(" #n ")" ::: "memory")
#define PG8_BAR __builtin_amdgcn_s_barrier()
#define PG8_SCHED __builtin_amdgcn_sched_barrier(0)
    Unit cur, nxt; int ui = 0;
    if (!S.next(0, cur)) return;
    f32x4 acc[2][2][4][2];
#pragma unroll
    for (int a = 0; a < 2; ++a)
#pragma unroll
        for (int b = 0; b < 2; ++b)
#pragma unroll
            for (int m = 0; m < 4; ++m)
#pragma unroll
                for (int n = 0; n < 2; ++n) acc[a][b][m][n] = (f32x4){0.f, 0.f, 0.f, 0.f};
    bf16x8 At[4][2], B0[2][2], B1[2][2];
    const char* cA = (const char*)g.A + (size_t)cur.pm * tstep; const char* cB = (const char*)g.Bt + (size_t)cur.pn * tstep;
    S.a_ready(cur);
    if constexpr (SP2) {
        PG8_STAGE(PG8_SB(0, 0), cB, voffB); PG8_STAGE(PG8_SB(0, 1), cB + hstep, voffB); PG8_STAGE(PG8_SA(0, 0), cA, voffA); PG8_STAGE(PG8_SA(0, 1), cA + hstep, voffA);
        if (wr == 1) PG8_BAR;
        PG8_WAIT_V(2); PG8_BAR;
        PG8_STAGE(PG8_SB(1, 0), cB + kstep, voffB); PG8_STAGE(PG8_SA(1, 0), cA + kstep, voffA); PG8_STAGE(PG8_SB(1, 1), cB + hstep + kstep, voffB);
        PG8_WAIT_V(6); PG8_BAR;
    } else {
        PG8_STAGE(PG8_SB(0, 0), cB, voffB); PG8_STAGE(PG8_SA(0, 0), cA, voffA); PG8_STAGE(PG8_SB(0, 1), cB + hstep, voffB); PG8_STAGE(PG8_SA(0, 1), cA + hstep, voffA);
        if (wr == 1) PG8_BAR;
        PG8_WAIT_V(4); PG8_BAR;
        PG8_STAGE(PG8_SB(1, 0), cB + kstep, voffB); PG8_STAGE(PG8_SA(1, 0), cA + kstep, voffA); PG8_STAGE(PG8_SB(1, 1), cB + hstep + kstep, voffB);
        PG8_WAIT_V(6); PG8_BAR;
    }
    for (;;) {
        const bool has_next = S.next(ui + 1, nxt);
        const char* nA = has_next ? (const char*)g.A + (size_t)nxt.pm * tstep : cA; const char* nB = has_next ? (const char*)g.Bt + (size_t)nxt.pn * tstep : cB;
        for (int t = 0; t < nt; t += 2) {
            const bool last = (t == nt - 2);
            const char* a1 = cA + (size_t)(t + 1) * kstep;
            const char* a2 = last ? nA : cA + (size_t)(t + 2) * kstep; const char* b2 = last ? nB : cB + (size_t)(t + 2) * kstep;
            const char* a3 = a2 + kstep; const char* b3 = b2 + kstep;
            if (last && has_next) S.a_ready(nxt);
            if constexpr (SP2) {
            PG8_LDB(B0, 0, 0); PG8_LDB(B1, 0, 1); PG8_SCHED; PG8_LDA(At, 0, 0); PG8_STAGE(PG8_SA(1, 1), a1 + hstep, voffA);
            PG8_WAIT_V(8); PG8_WAIT_L(0); PG8_BAR; PG8_MMA(0, 0, At, B0); PG8_MMA(0, 1, At, B1); PG8_BAR; PG8_SCHED;
            PG8_LDA(At, 0, 1); PG8_STAGE(PG8_SB(0, 0), b2, voffB); PG8_STAGE(PG8_SB(0, 1), b2 + hstep, voffB); PG8_STAGE(PG8_SA(0, 0), a2, voffA);
            PG8_WAIT_V(8); PG8_WAIT_L(0); PG8_BAR; PG8_MMA(1, 0, At, B0); PG8_MMA(1, 1, At, B1); PG8_BAR; PG8_SCHED;
            PG8_LDB(B0, 1, 0); PG8_LDB(B1, 1, 1); PG8_SCHED; PG8_LDA(At, 1, 0); PG8_STAGE(PG8_SA(0, 1), a2 + hstep, voffA);
            PG8_WAIT_V(8); PG8_WAIT_L(0); PG8_BAR; PG8_MMA(0, 0, At, B0); PG8_MMA(0, 1, At, B1); PG8_BAR; PG8_SCHED;
            PG8_LDA(At, 1, 1); PG8_STAGE(PG8_SB(1, 0), b3, voffB); PG8_STAGE(PG8_SB(1, 1), b3 + hstep, voffB); PG8_STAGE(PG8_SA(1, 0), a3, voffA);
            PG8_WAIT_V(8); PG8_WAIT_L(0); PG8_BAR; PG8_MMA(1, 0, At, B0); PG8_MMA(1, 1, At, B1); PG8_BAR; PG8_SCHED;
            } else {
            PG8_LDB(B0, 0, 0); PG8_SCHED; PG8_LDA(At, 0, 0); PG8_STAGE(PG8_SA(1, 1), a1 + hstep, voffA);
            PG8_WAIT_L(8); PG8_BAR; PG8_WAIT_L(0); PG8_MMA(0, 0, At, B0); PG8_BAR; PG8_SCHED;
            PG8_LDB(B1, 0, 1); PG8_STAGE(PG8_SB(0, 0), b2, voffB);
            PG8_BAR; PG8_WAIT_L(0); PG8_MMA(0, 1, At, B1); PG8_BAR;
            PG8_LDA(At, 0, 1); PG8_STAGE(PG8_SA(0, 0), a2, voffA);
            PG8_BAR; PG8_WAIT_L(0); PG8_MMA(1, 0, At, B0); PG8_BAR; PG8_SCHED;
            PG8_STAGE(PG8_SB(0, 1), b2 + hstep, voffB);
            PG8_WAIT_V(6); PG8_BAR; PG8_MMA(1, 1, At, B1); PG8_BAR;
            PG8_LDB(B0, 1, 0); PG8_SCHED; PG8_LDA(At, 1, 0); PG8_STAGE(PG8_SA(0, 1), a2 + hstep, voffA);
            PG8_WAIT_L(8); PG8_BAR; PG8_WAIT_L(0); PG8_MMA(0, 0, At, B0); PG8_BAR; PG8_SCHED;
            PG8_LDB(B1, 1, 1); PG8_STAGE(PG8_SB(1, 0), b3, voffB);
            PG8_BAR; PG8_WAIT_L(0); PG8_MMA(0, 1, At, B1); PG8_BAR;
            PG8_LDA(At, 1, 1); PG8_STAGE(PG8_SA(1, 0), a3, voffA);
            PG8_BAR; PG8_WAIT_L(0); PG8_MMA(1, 0, At, B0); PG8_BAR; PG8_SCHED;
            PG8_STAGE(PG8_SB(1, 1), b3 + hstep, voffB);
            PG8_WAIT_V(6); PG8_BAR; PG8_MMA(1, 1, At, B1); PG8_BAR;
            }
        }
        if constexpr (ALIGN_EPI) { if (wr == 0) PG8_BAR; }
        if constexpr (!Epi::AFTER_DRAIN) { E(acc, cur, wr, wc, fr, fq); S.done(cur); }
        if (!has_next) break;
#pragma unroll
        for (int a = 0; a < 2; ++a)
#pragma unroll
            for (int b = 0; b < 2; ++b)
#pragma unroll
                for (int m = 0; m < 4; ++m)
#pragma unroll
                    for (int n = 0; n < 2; ++n) acc[a][b][m][n] = (f32x4){0.f, 0.f, 0.f, 0.f};
        cur = nxt; cA = nA; cB = nB; ++ui;
        if constexpr (ALIGN_EPI) { if (wr == 1) PG8_BAR; }
    }
    PG8_WAIT_V(0);
    if constexpr (!ALIGN_EPI) { if (wr == 0) PG8_BAR; }
    PG8_BAR;
    if constexpr (Epi::AFTER_DRAIN) { E.fused(acc, cur, wr, wc, fr, fq, lds, wid, lane); S.done(cur); }
#undef PG8_SA
#undef PG8_SB
#undef PG8_STAGE
#undef PG8_LDA
#undef PG8_LDB
#undef PG8_MMA
#undef PG8_WAIT_V
#undef PG8_WAIT_L
#undef PG8_BAR
#undef PG8_SCHED
}
}
constexpr int BATCH = 4, SEQ = 4096, DM = 1024, MROWS = BATCH * SEQ;
constexpr int NMEM = 256, MEMROWS = BATCH * NMEM;
constexpr int PP = 3584;
constexpr int INW = 3592, DFF = 2816;
constexpr int C_RQ = 0, C_RK = 512, C_RV = 1024, C_RG = 1536, C_FQ = 2048, C_FK = 2560, C_FV = 3072;
constexpr float EPS = 1e-6f, LOG2E = 1.4426950408889634f;
constexpr float C2F = 0.125f * LOG2E;
constexpr int NTHR = 512, NWAVES = 8;
constexpr int LDS_BYTES = 147456;

constexpr size_t MiB = 1u << 20;
constexpr size_t WS_WIN = 2 * MiB, WS_WOUT = 10 * MiB, WS_WXQ = 12 * MiB, WS_WXKV = 14 * MiB, WS_WXO = 18 * MiB, WS_WGU = 20 * MiB, WS_WD = 32 * MiB;
constexpr size_t WS_COS = 38 * MiB, WS_SIN = 38 * MiB + 512 * 1024, WS_LOGF = 39 * MiB, WS_FC = 39 * MiB + 512 * 1024;
constexpr size_t WS_MEMN = 40 * MiB, WS_KVM = 42 * MiB, WS_KSS = 46 * MiB, WS_SS1 = 47 * MiB, WS_QSS = 48 * MiB, WS_SS2 = 49 * MiB;
constexpr size_t WS_HN = 64 * MiB;
constexpr size_t WS_P = 96 * MiB;
constexpr size_t WS_KVT = 208 * MiB;
constexpr size_t WS_ST = 240 * MiB;
constexpr size_t WS_H1B = 96 * MiB;
constexpr size_t WS_QX = 128 * MiB;
constexpr size_t WS_O = 160 * MiB;
constexpr size_t WS_ACT = 128 * MiB;
constexpr size_t WS_END = 256 * MiB;

typedef unsigned short bf16_t;
typedef short bf16x8 __attribute__((ext_vector_type(8)));
typedef short s16x4 __attribute__((ext_vector_type(4)));
typedef float f32x4 __attribute__((ext_vector_type(4)));
typedef float f32x16 __attribute__((ext_vector_type(16)));
typedef unsigned u32x4 __attribute__((ext_vector_type(4)));
typedef unsigned u32x2 __attribute__((ext_vector_type(2)));
#define LAS __attribute__((address_space(3)))
typedef LAS unsigned char* ldsp_t;

__device__ __forceinline__ unsigned pkbf(float lo, float hi) {
    typedef float f2 __attribute__((ext_vector_type(2))); typedef __bf16 b2 __attribute__((ext_vector_type(2)));
    f2 v = {lo, hi}; b2 b = __builtin_convertvector(v, b2); return __builtin_bit_cast(unsigned, b);
}
__device__ __forceinline__ void st16(void* ptr, u32x4 v) { *(u32x4*)ptr = v; }
__device__ __forceinline__ void st16f(void* ptr, f32x4 v) { *(f32x4*)ptr = v; }
__device__ __forceinline__ void st8(void* ptr, u32x2 v) { *(u32x2*)ptr = v; }
__device__ __forceinline__ float bflo(unsigned u) { return __uint_as_float(u << 16); }
__device__ __forceinline__ float bfhi(unsigned u) { return __uint_as_float(u & 0xffff0000u); }
__device__ __forceinline__ int crow(int r, int hi) { return (r & 3) + 8 * (r >> 2) + 4 * hi; }
__device__ __forceinline__ float wave_sum(float v) {
#pragma unroll
    for (int o = 1; o < 64; o <<= 1) v += __shfl_xor(v, o);
    return v;
}
__device__ __forceinline__ s16x4 tr_rd(ldsp_t p) {
    typedef short v4i16_t __attribute__((ext_vector_type(4)));
    return __builtin_bit_cast(s16x4, __builtin_amdgcn_ds_read_tr16_b64_v4i16((LAS v4i16_t*)p));
}
__device__ __forceinline__ bf16x8 cat8(s16x4 lo, s16x4 hi) { return __builtin_shufflevector(lo, hi, 0, 1, 2, 3, 4, 5, 6, 7); }
#define MFMA32(a, b, c) __builtin_amdgcn_mfma_f32_32x32x16_bf16((a), (b), (c), 0, 0, 0)
__device__ __forceinline__ bf16x8 pack8(const f32x16& x, int s) {
    u32x4 p; p.x = pkbf(x[8 * s], x[8 * s + 1]); p.y = pkbf(x[8 * s + 2], x[8 * s + 3]); p.z = pkbf(x[8 * s + 4], x[8 * s + 5]); p.w = pkbf(x[8 * s + 6], x[8 * s + 7]);
    return __builtin_bit_cast(bf16x8, p);
}


#define GAS __attribute__((address_space(1)))
#define XB_TMO      128
#define XB_XCNT(j)  (256  + 64 * (j))
#define XB_XSUB(j)  (1280 + 64 * (j))
#define XB_XGEN(j)  (2304 + 64 * (j))
#define XB_TOP      3328
#define XB_TOPGEN   3392
#define XCD_BAR_WORDS 3456
#define XB_SPIN_CAP (1u << 18)

__device__ __forceinline__ unsigned xb_ld(unsigned* p)              { return __hip_atomic_load(p, __ATOMIC_RELAXED, __HIP_MEMORY_SCOPE_AGENT); }
__device__ __forceinline__ unsigned xb_add(unsigned* p, unsigned v) { return __hip_atomic_fetch_add(p, v, __ATOMIC_RELAXED, __HIP_MEMORY_SCOPE_AGENT); }
__device__ __forceinline__ unsigned xb_xcc_id() { return (unsigned)__builtin_amdgcn_s_getreg((3 << 11) | 20) & 0xFu; }
#define XB_SPIN(cond, bar) do { unsigned _sp = 0; while (cond) { __builtin_amdgcn_s_sleep(1); \
    if ((++_sp & 255u) == 0u) { if (xb_ld(&(bar)[XB_TMO])) break; if (_sp > XB_SPIN_CAP) { atomicAdd(&(bar)[XB_TMO], 1u); break; } } } } while (0)

struct XcdBarrier {
    unsigned* bar; unsigned x;
    volatile LAS unsigned* st;
};

__device__ __forceinline__ XcdBarrier xcd_barrier_post(unsigned* bar, volatile LAS unsigned* st) {
    XcdBarrier b; b.bar = bar; b.x = xb_xcc_id(); b.st = st;
    if (threadIdx.x == 0) (void)xb_add(&bar[XB_XCNT(b.x)], 1u);
    return b;
}
__device__ __forceinline__ void xcd_barrier_complete(unsigned* bar, unsigned x, unsigned& nloc, unsigned& nx) {
    const unsigned G = gridDim.x * gridDim.y * gridDim.z;
    unsigned sum, cnt, mine, sp = 0u;
    for (;;) {
        sum = 0u; cnt = 0u; mine = 0u;
#pragma unroll
        for (unsigned j = 0; j < 16; ++j) { const unsigned c = xb_ld(&bar[XB_XCNT(j)]); sum += c; cnt += (c > 0u) ? 1u : 0u; mine = (j == x) ? c : mine; }
        if (sum == G) break;
        __builtin_amdgcn_s_sleep(1);
        if ((++sp & 255u) == 0u) { if (xb_ld(&bar[XB_TMO])) break; if (sp > XB_SPIN_CAP) { atomicAdd(&bar[XB_TMO], 1u); break; } }
    }
    nloc = mine > 0u ? mine : 1u; nx = cnt > 0u ? cnt : 1u;
}

__device__ __forceinline__ void xcd_barrier(const XcdBarrier& b) {
    asm volatile("s_waitcnt vmcnt(0)" ::: "memory");
    __syncthreads();
    if (threadIdx.x == 0) {
        unsigned* bar = b.bar;
        __builtin_amdgcn_s_waitcnt(0);
        unsigned nloc = b.st[0], nx = b.st[1];
        if (nloc == 0u) { xcd_barrier_complete(bar, b.x, nloc, nx); b.st[0] = nloc; b.st[1] = nx; }
        const unsigned old = xb_add(&bar[XB_XSUB(b.x)], 1u);
        const unsigned gen = old / nloc;
        if (old + 1u == (gen + 1u) * nloc) {
            __builtin_amdgcn_fence(__ATOMIC_RELEASE, "agent");
            asm volatile("s_waitcnt vmcnt(0)" ::: "memory");
            const unsigned og = xb_add(&bar[XB_TOP], 1u);
            const unsigned tg = og / nx;
            if (og + 1u == (tg + 1u) * nx) xb_add(&bar[XB_TOPGEN], 1u);
            else XB_SPIN(xb_ld(&bar[XB_TOPGEN]) == tg, bar);
            xb_add(&bar[XB_XGEN(b.x)], 1u);
            __builtin_amdgcn_fence(__ATOMIC_ACQUIRE, "agent");
            asm volatile("s_waitcnt vmcnt(0)" ::: "memory");
        } else {
            XB_SPIN(xb_ld(&bar[XB_XGEN(b.x)]) == gen, bar);
            __builtin_amdgcn_fence(__ATOMIC_ACQUIRE, "agent");
            asm volatile("s_waitcnt vmcnt(0)" ::: "memory");
        }
    }
    __syncthreads();
}


namespace pg8 {
struct EpiProj {
    static constexpr bool PERM = true, AFTER_DRAIN = false;
    bf16_t* P; const float* cs; const float* sn; const float* gq; const float* gk;
    __device__ __forceinline__ void operator()(const f32x4 (&acc)[2][2][4][2], const Unit& u, int wr, int wc, int fr, int fq) const {
        const int seg = u.pn >> 1;
        const int row0 = u.pm * BM + wr * 64 + fr;
        const int colbase = u.pn * 256 + 64 * wc + 8 * fq;
        if (seg == 0 || seg == 1) {
#pragma unroll
            for (int ai = 0; ai < 2; ++ai)
#pragma unroll
                for (int m = 0; m < 4; ++m) {
                    const int row = row0 + ai * HALF + m * 16; const int pos = row & (SEQ - 1);
                    const float* cp = cs + pos * 32 + 8 * fq; const float* sp = sn + pos * 32 + 8 * fq;
                    u32x4 w1, w2;
                    { const f32x4 c = *(const f32x4*)cp, s = *(const f32x4*)sp; const f32x4 x1 = acc[ai][0][m][0], x2 = acc[ai][1][m][0];
                      const f32x4 o1 = x1 * c - x2 * s, o2 = x1 * s + x2 * c; w1.x = pkbf(o1[0], o1[1]); w1.y = pkbf(o1[2], o1[3]); w2.x = pkbf(o2[0], o2[1]); w2.y = pkbf(o2[2], o2[3]); }
                    { const f32x4 c = *(const f32x4*)(cp + 4), s = *(const f32x4*)(sp + 4); const f32x4 x1 = acc[ai][0][m][1], x2 = acc[ai][1][m][1];
                      const f32x4 o1 = x1 * c - x2 * s, o2 = x1 * s + x2 * c; w1.z = pkbf(o1[0], o1[1]); w1.w = pkbf(o1[2], o1[3]); w2.z = pkbf(o2[0], o2[1]); w2.w = pkbf(o2[2], o2[3]); }
                    bf16_t* rp = P + (size_t)row * PP + colbase;
                    st16(rp, w1); st16(rp + 32, w2);
                }
        } else if (seg == 4 || seg == 5) {
            const float* g = (seg == 4) ? gq : gk; const float sc = (seg == 4) ? C2F : 1.0f;
            f32x4 gv[2][2];
#pragma unroll
            for (int bj = 0; bj < 2; ++bj)
#pragma unroll
                for (int n = 0; n < 2; ++n) gv[bj][n] = *(const f32x4*)(g + 32 * bj + 8 * fq + 4 * n);
#pragma unroll
            for (int ai = 0; ai < 2; ++ai)
#pragma unroll
                for (int m = 0; m < 4; ++m) {
                    const int row = row0 + ai * HALF + m * 16;
                    float ss = 0.f;
#pragma unroll
                    for (int bj = 0; bj < 2; ++bj)
#pragma unroll
                        for (int n = 0; n < 2; ++n) { const f32x4 x = acc[ai][bj][m][n]; ss += (x[0] * x[0] + x[1] * x[1]) + (x[2] * x[2] + x[3] * x[3]); }
                    ss += __shfl_xor(ss, 16); ss += __shfl_xor(ss, 32);
                    const float rs = rsqrtf(ss * (1.0f / 64.0f) + EPS) * sc;
                    bf16_t* rp = P + (size_t)row * PP + colbase;
#pragma unroll
                    for (int bj = 0; bj < 2; ++bj) { const f32x4 a = acc[ai][bj][m][0] * gv[bj][0] * rs, b = acc[ai][bj][m][1] * gv[bj][1] * rs;
                        u32x4 w; w.x = pkbf(a[0], a[1]); w.y = pkbf(a[2], a[3]); w.z = pkbf(b[0], b[1]); w.w = pkbf(b[2], b[3]); st16(rp + 32 * bj, w); }
                }
        } else {
#pragma unroll
            for (int ai = 0; ai < 2; ++ai)
#pragma unroll
                for (int m = 0; m < 4; ++m) {
                    const int row = row0 + ai * HALF + m * 16; bf16_t* rp = P + (size_t)row * PP + colbase;
#pragma unroll
                    for (int bj = 0; bj < 2; ++bj) { const f32x4 a = acc[ai][bj][m][0], b = acc[ai][bj][m][1];
                        u32x4 w; w.x = pkbf(a[0], a[1]); w.y = pkbf(a[2], a[3]); w.z = pkbf(b[0], b[1]); w.w = pkbf(b[2], b[3]); st16(rp + 32 * bj, w); }
                }
        }
    }
};
struct EpiKV {
    static constexpr bool PERM = true, AFTER_DRAIN = false;
    bf16_t* O; float* kss; const float* gxq; const float* gxk;
    __device__ __forceinline__ void operator()(const f32x4 (&acc)[2][2][4][2], const Unit& u, int wr, int wc, int fr, int fq) const {
        const int row0 = u.pm * BM + wr * 64 + fr; const int col0 = u.pn * BM + wc * 32 + 8 * fq; const bool isk = u.pn < 4;
        f32x4 gv[2][2];
#pragma unroll
        for (int bj = 0; bj < 2; ++bj)
#pragma unroll
            for (int n = 0; n < 2; ++n) { const int c = (col0 + bj * HALF + 4 * n) & 255;
                gv[bj][n] = isk ? (*(const f32x4*)(gxq + c)) * (*(const f32x4*)(gxk + c)) : (f32x4){1.f, 1.f, 1.f, 1.f}; }
#pragma unroll
        for (int ai = 0; ai < 2; ++ai)
#pragma unroll
            for (int m = 0; m < 4; ++m) {
                const int row = row0 + ai * HALF + m * 16; float ss = 0.f;
                bf16_t* rp = O + (size_t)row * 2048 + col0;
#pragma unroll
                for (int bj = 0; bj < 2; ++bj) { const f32x4 a0 = acc[ai][bj][m][0], b0 = acc[ai][bj][m][1];
                    ss += (a0[0] * a0[0] + a0[1] * a0[1]) + (a0[2] * a0[2] + a0[3] * a0[3]) + (b0[0] * b0[0] + b0[1] * b0[1]) + (b0[2] * b0[2] + b0[3] * b0[3]);
                    const f32x4 a = a0 * gv[bj][0], b = b0 * gv[bj][1];
                    u32x4 w; w.x = pkbf(a[0], a[1]); w.y = pkbf(a[2], a[3]); w.z = pkbf(b[0], b[1]); w.w = pkbf(b[2], b[3]); st16(rp + bj * HALF, w); }
                ss += __shfl_xor(ss, 16); ss += __shfl_xor(ss, 32);
                if (isk && fq == 0) kss[(size_t)row * 16 + u.pn * 4 + wc] = ss;
            }
    }
};
template <bool BB> struct EpiRes {
    static constexpr bool PERM = true, AFTER_DRAIN = false;
    const void* base; float* out; bf16_t* hb; float* ssp;
    __device__ __forceinline__ void operator()(const f32x4 (&acc)[2][2][4][2], const Unit& u, int wr, int wc, int fr, int fq) const {
        const int row0 = u.pm * BM + wr * 64 + fr; const int col0 = u.pn * BM + wc * 32 + 8 * fq;
#pragma unroll
        for (int ai = 0; ai < 2; ++ai) {
            f32x4 rb[4][2][2];
#pragma unroll
            for (int m = 0; m < 4; ++m) { const size_t off = (size_t)(row0 + ai * HALF + m * 16) * DM + col0;
#pragma unroll
                for (int bj = 0; bj < 2; ++bj) {
                    if constexpr (BB) { const u32x4 w = *(const u32x4*)((const bf16_t*)base + off + bj * HALF);
                        rb[m][bj][0] = (f32x4){bflo(w.x), bfhi(w.x), bflo(w.y), bfhi(w.y)}; rb[m][bj][1] = (f32x4){bflo(w.z), bfhi(w.z), bflo(w.w), bfhi(w.w)}; }
                    else { rb[m][bj][0] = __builtin_nontemporal_load((const f32x4*)((const float*)base + off + bj * HALF)); rb[m][bj][1] = __builtin_nontemporal_load((const f32x4*)((const float*)base + off + bj * HALF + 4)); } } }
#pragma unroll
            for (int m = 0; m < 4; ++m) {
                const int row = row0 + ai * HALF + m * 16; float ss = 0.f; const size_t off = (size_t)row * DM + col0;
#pragma unroll
                for (int bj = 0; bj < 2; ++bj) {
                    const f32x4 a = rb[m][bj][0] + acc[ai][bj][m][0], b = rb[m][bj][1] + acc[ai][bj][m][1];
                    if (out) { __builtin_nontemporal_store(a, (f32x4*)(out + off + bj * HALF)); __builtin_nontemporal_store(b, (f32x4*)(out + off + bj * HALF + 4)); }
                    ss += (a[0] * a[0] + a[1] * a[1]) + (a[2] * a[2] + a[3] * a[3]) + (b[0] * b[0] + b[1] * b[1]) + (b[2] * b[2] + b[3] * b[3]);
                    if (hb) { u32x4 w; w.x = pkbf(a[0], a[1]); w.y = pkbf(a[2], a[3]); w.z = pkbf(b[0], b[1]); w.w = pkbf(b[2], b[3]); st16(hb + off + bj * HALF, w); }
                }
                if (ssp) { ss += __shfl_xor(ss, 16); ss += __shfl_xor(ss, 32); if (fq == 0) ssp[(size_t)row * 16 + u.pn * 4 + wc] = ss; }
            }
        }
    }
};
struct EpiXq {
    static constexpr bool PERM = true, AFTER_DRAIN = false;
    bf16_t* O; float* qss;
    __device__ __forceinline__ void operator()(const f32x4 (&acc)[2][2][4][2], const Unit& u, int wr, int wc, int fr, int fq) const {
        const int row0 = u.pm * BM + wr * 64 + fr; const int col0 = u.pn * BM + wc * 32 + 8 * fq;
#pragma unroll
        for (int ai = 0; ai < 2; ++ai)
#pragma unroll
            for (int m = 0; m < 4; ++m) {
                const int row = row0 + ai * HALF + m * 16; float ss = 0.f; bf16_t* rp = O + (size_t)row * DM + col0;
#pragma unroll
                for (int bj = 0; bj < 2; ++bj) { const f32x4 a = acc[ai][bj][m][0], b = acc[ai][bj][m][1];
                    ss += (a[0] * a[0] + a[1] * a[1]) + (a[2] * a[2] + a[3] * a[3]) + (b[0] * b[0] + b[1] * b[1]) + (b[2] * b[2] + b[3] * b[3]);
                    u32x4 w; w.x = pkbf(a[0], a[1]); w.y = pkbf(a[2], a[3]); w.z = pkbf(b[0], b[1]); w.w = pkbf(b[2], b[3]); st16(rp + bj * HALF, w); }
                ss += __shfl_xor(ss, 16); ss += __shfl_xor(ss, 32);
                if (fq == 0) qss[(size_t)row * 16 + u.pn * 4 + wc] = ss;
            }
    }
};
struct EpiGU {
    static constexpr bool PERM = true, AFTER_DRAIN = false;
    bf16_t* A; const float* ss2; const LAS float* rl;
    __device__ __forceinline__ void operator()(const f32x4 (&acc)[2][2][4][2], const Unit& u, int wr, int wc, int fr, int fq) const {
        const int row0 = u.pm * BM + wr * 64 + fr; const int col0 = u.pn * 128 + wc * 32 + 8 * fq;
#pragma unroll
        for (int ai = 0; ai < 2; ++ai)
#pragma unroll
            for (int m = 0; m < 4; ++m) {
                const int row = row0 + ai * HALF + m * 16;
                float r;
                if (rl) r = rl[ai * HALF + wr * 64 + m * 16 + fr];
                else { const f32x4* sp = (const f32x4*)(ss2 + (size_t)row * 16); const f32x4 s0 = sp[0], s1 = sp[1], s2 = sp[2], s3 = sp[3];
                    const float tot = ((s0[0] + s0[1]) + (s0[2] + s0[3])) + ((s1[0] + s1[1]) + (s1[2] + s1[3])) + ((s2[0] + s2[1]) + (s2[2] + s2[3])) + ((s3[0] + s3[1]) + (s3[2] + s3[3]));
                    r = rsqrtf(tot * (1.0f / 1024.0f) + EPS); }
                float o[8];
#pragma unroll
                for (int n = 0; n < 2; ++n)
#pragma unroll
                    for (int e = 0; e < 4; ++e) { const float g = acc[ai][0][m][n][e] * r, up = acc[ai][1][m][n][e] * r;
                        o[4 * n + e] = g * __builtin_amdgcn_rcpf(1.0f + __builtin_amdgcn_exp2f(-g * LOG2E)) * up; }
                u32x4 w; w.x = pkbf(o[0], o[1]); w.y = pkbf(o[2], o[3]); w.z = pkbf(o[4], o[5]); w.w = pkbf(o[6], o[7]);
                st16(A + (size_t)row * DFF + col0, w);
            }
    }
};
}

struct WItem { const float* W; const float* gain; bf16_t* WT; int ldw, src_col0, ldt, dst_row0, k0; };
__device__ __forceinline__ void witem_load(const WItem& w, f32x4 (&v)[8], int lane) {
    const int c4 = (lane & 7) * 4, kr = lane >> 3;
#pragma unroll
    for (int i = 0; i < 8; ++i) v[i] = __builtin_nontemporal_load((const f32x4*)(w.W + (size_t)(w.k0 + 8 * i + kr) * w.ldw + w.src_col0 + c4));
}
__device__ __forceinline__ void witem_finish(const WItem& w, const f32x4 (&v)[8], LAS float* scr, int lane) {
    const int c4 = (lane & 7) * 4, kr = lane >> 3;
#pragma unroll
    for (int i = 0; i < 8; ++i) { const int kk = 8 * i + kr; const float g = w.gain ? w.gain[w.k0 + kk] : 1.0f;
        scr[kk * 33 + c4] = v[i][0] * g; scr[kk * 33 + c4 + 1] = v[i][1] * g; scr[kk * 33 + c4 + 2] = v[i][2] * g; scr[kk * 33 + c4 + 3] = v[i][3] * g; }
    asm volatile("s_waitcnt lgkmcnt(0)" ::: "memory");
    const int c = lane & 7;
#pragma unroll
    for (int j = 0; j < 4; ++j) { const int n = (lane >> 3) + 8 * j; const LAS float* s = scr + (8 * c) * 33 + n;
        u32x4 o; o.x = pkbf(s[0 * 33], s[1 * 33]); o.y = pkbf(s[2 * 33], s[3 * 33]); o.z = pkbf(s[4 * 33], s[5 * 33]); o.w = pkbf(s[6 * 33], s[7 * 33]);
        *(u32x4*)(w.WT + (size_t)(w.dst_row0 + n) * w.ldt + w.k0 + 8 * c) = o; }
    asm volatile("s_waitcnt lgkmcnt(0)" ::: "memory");
}

struct Params {
    const float* in[20];
    float* out;
    unsigned char* ws;
};

constexpr int I_IN = 16 * 112, I_XKV = 16 * 64, I_OUT = 16 * 32, I_XQ = 16 * 32, I_XO = 16 * 32, I_GU = 16 * 176, I_D = 44 * 32;
#ifndef LATE_WEIGHTS
#define LATE_WEIGHTS 1
#endif
#define LATE_W (LATE_WEIGHTS && G == 256)
constexpr int W_P1 = I_IN + I_XKV, W_EARLY = W_P1 + I_D, W_ALL = W_EARLY + I_OUT + I_XQ + I_XO + I_GU;
__device__ __forceinline__ WItem witem_decode(const Params& p, int it) {
    unsigned char* ws = p.ws; WItem w; w.gain = nullptr; int r = it;
    if (r < I_IN) { const int kb = r / 112, nb = r % 112, p0 = 32 * nb, pt = p0 >> 8, pp = p0 & 255;
        w.W = p.in[3]; w.ldw = INW; w.src_col0 = 256 * pt + 64 * ((pp >> 5) & 3) + 32 * (pp >> 7); w.WT = (bf16_t*)(ws + WS_WIN); w.ldt = 1024; w.dst_row0 = p0; w.k0 = 64 * kb; return w; } r -= I_IN;
    if (r < I_XKV) { const int kb = r / 64, nb = r % 64; w.W = p.in[11]; w.ldw = 2048; w.src_col0 = 32 * nb; w.WT = (bf16_t*)(ws + WS_WXKV); w.ldt = 1024; w.dst_row0 = 32 * nb; w.k0 = 64 * kb; return w; } r -= I_XKV;
    if (r < I_D) { const int kb = r / 32, nb = r % 32; w.W = p.in[19]; w.ldw = 1024; w.src_col0 = 32 * nb; w.WT = (bf16_t*)(ws + WS_WD); w.ldt = DFF; w.dst_row0 = 32 * nb; w.k0 = 64 * kb; return w; } r -= I_D;
    if (r < I_OUT) { const int kb = r / 32, nb = r % 32; w.W = p.in[8]; w.ldw = 1024; w.src_col0 = 32 * nb; w.WT = (bf16_t*)(ws + WS_WOUT); w.ldt = 1024; w.dst_row0 = 32 * nb; w.k0 = 64 * kb; return w; } r -= I_OUT;
    if (r < I_XQ) { const int kb = r / 32, nb = r % 32; w.W = p.in[10]; w.gain = p.in[9]; w.ldw = 1024; w.src_col0 = 32 * nb; w.WT = (bf16_t*)(ws + WS_WXQ); w.ldt = 1024; w.dst_row0 = 32 * nb; w.k0 = 64 * kb; return w; } r -= I_XQ;
    if (r < I_XO) { const int kb = r / 32, nb = r % 32; w.W = p.in[15]; w.ldw = 1024; w.src_col0 = 32 * nb; w.WT = (bf16_t*)(ws + WS_WXO); w.ldt = 1024; w.dst_row0 = 32 * nb; w.k0 = 64 * kb; return w; } r -= I_XO;
    { const int kb = r / 176, nb = r % 176, p0 = 32 * nb, pt = p0 >> 8, pp = p0 & 255;
        w.W = (pp >> 7) ? p.in[18] : p.in[17]; w.gain = p.in[16]; w.ldw = DFF; w.src_col0 = 128 * pt + (pp & 127); w.WT = (bf16_t*)(ws + WS_WGU); w.ldt = 1024; w.dst_row0 = p0; w.k0 = 64 * kb; return w; }
    return w;
}

__device__ __forceinline__ void weight_items(const Params& p, LAS float* scr, int lane, int gw, int NGW, int first, int last) {
    int it = first + gw;
    if (it >= last) return;
    WItem cur = witem_decode(p, it); f32x4 v[8]; witem_load(cur, v, lane);
    for (;;) {
        const int nx = it + NGW; const bool more = nx < last;
        WItem nw = cur; f32x4 vn[8];
        if (more) { nw = witem_decode(p, nx); witem_load(nw, vn, lane); }
        witem_finish(cur, v, scr, lane);
        if (!more) break;
        cur = nw; it = nx;
#pragma unroll
        for (int i = 0; i < 8; ++i) v[i] = vn[i];
    }
}

__device__ __forceinline__ void p0_prologue(const Params& p, ldsp_t lds, int vcu, int G) {
    const int tid = threadIdx.x, lane = tid & 63, wave = __builtin_amdgcn_readfirstlane(tid >> 6);
    unsigned char* ws = p.ws;
    const float* x = p.in[0]; const float* mem = p.in[1]; const float* g_mix = p.in[2]; const float* w_in = p.in[3]; const float* b_forget = p.in[4];
    const float* w_out = p.in[8]; const float* g_xattn = p.in[9]; const float* w_xq = p.in[10]; const float* w_xkv = p.in[11]; const float* g_mem = p.in[12];
    const float* w_xo = p.in[15]; const float* g_ffn = p.in[16]; const float* w_gate = p.in[17]; const float* w_up = p.in[18]; const float* w_down = p.in[19];
    LAS float* scr = (LAS float*)(lds + wave * 8448);
    LAS float* wfT = (LAS float*)(lds + 98304);
    float wfv[16];
#pragma unroll
    for (int j = 0; j < 16; ++j) { const int i = tid + j * NTHR, k = i >> 3, c = i & 7; wfv[j] = w_in[(size_t)k * INW + 3584 + c] * g_mix[k]; }
    const int gw = vcu * NWAVES + wave, NGW = G * NWAVES;
    f32x4 gm[4], vn[4], vn2[4], mv[4];
#pragma unroll
    for (int j = 0; j < 4; ++j) gm[j] = ((const f32x4*)g_mix)[lane + 64 * j];
    if (gw < MROWS) {
#pragma unroll
        for (int j = 0; j < 4; ++j) vn[j] = __builtin_nontemporal_load((const f32x4*)(x + (size_t)gw * DM) + lane + 64 * j);
    }
    if (gw + NGW < MROWS) {
#pragma unroll
        for (int j = 0; j < 4; ++j) vn2[j] = __builtin_nontemporal_load((const f32x4*)(x + (size_t)(gw + NGW) * DM) + lane + 64 * j);
    }
    if (gw < MEMROWS) {
#pragma unroll
        for (int j = 0; j < 4; ++j) mv[j] = __builtin_nontemporal_load((const f32x4*)(mem + (size_t)gw * DM) + lane + 64 * j);
    }
    {
        float* cs = (float*)(ws + WS_COS); float* sn = (float*)(ws + WS_SIN);
        for (int e = vcu * NTHR + tid; e < SEQ * 32; e += G * NTHR) {
            const int t = e >> 5, i = e & 31;
            double invf = 1.0; for (int k = 0; k < i; ++k) invf *= 0.74989420933245582730;
            const double rev = (double)t * invf * 0.15915494309189533577;
            const float fr = (float)(rev - __builtin_rint(rev));
            cs[e] = __builtin_amdgcn_cosf(fr); sn[e] = __builtin_amdgcn_sinf(fr);
        }
    }
    weight_items(p, scr, lane, gw, NGW, 0, LATE_W ? W_P1 : W_ALL);
#pragma unroll
    for (int j = 0; j < 16; ++j) { const int i = tid + j * NTHR, k = i >> 3, c = i & 7; wfT[c * 1024 + k] = wfv[j]; }
    __syncthreads();
    {
        bf16_t* hn = (bf16_t*)(ws + WS_HN); float* logf = (float*)(ws + WS_LOGF);
        for (int m = gw; m < MROWS; m += NGW) {
            f32x4 v[4]; float s = 0.f;
#pragma unroll
            for (int j = 0; j < 4; ++j) { v[j] = vn[j]; vn[j] = vn2[j]; s += (v[j][0] * v[j][0] + v[j][1] * v[j][1]) + (v[j][2] * v[j][2] + v[j][3] * v[j][3]); }
            if (m + 2 * NGW < MROWS) {
#pragma unroll
                for (int j = 0; j < 4; ++j) vn2[j] = __builtin_nontemporal_load((const f32x4*)(x + (size_t)(m + 2 * NGW) * DM) + lane + 64 * j);
            }
            const float rs = rsqrtf(wave_sum(s) * (1.0f / 1024.0f) + EPS);
            float ff[8];
#pragma unroll
            for (int c = 0; c < 8; ++c) { float a = 0.f;
#pragma unroll
                for (int j = 0; j < 4; ++j) { const f32x4 w = *(const LAS f32x4*)(wfT + c * 1024 + 256 * j + 4 * lane); a += (v[j][0] * w[0] + v[j][1] * w[1]) + (v[j][2] * w[2] + v[j][3] * w[3]); }
                ff[c] = wave_sum(a) * rs; }
            unsigned long long* o8 = (unsigned long long*)(hn + (size_t)m * DM) + lane;
#pragma unroll
            for (int j = 0; j < 4; ++j) { const f32x4 y = v[j] * gm[j] * rs; o8[64 * j] = (unsigned long long)pkbf(y[0], y[1]) | ((unsigned long long)pkbf(y[2], y[3]) << 32); }
            if (lane < 8) { float z = 0.f;
#pragma unroll
                for (int c = 0; c < 8; ++c) if (lane == c) z = ff[c];
                z += b_forget[lane];
                logf[(size_t)m * 8 + lane] = fminf(z, 0.f) - log1pf(__expf(-fabsf(z))); }
        }
#pragma unroll
        for (int j = 0; j < 4; ++j) gm[j] = ((const f32x4*)g_mem)[lane + 64 * j];
        bf16_t* memn = (bf16_t*)(ws + WS_MEMN);
        for (int m = gw; m < MEMROWS; m += NGW) {
            const f32x4* xr = (const f32x4*)(mem + (size_t)m * DM) + lane;
            f32x4 v[4]; float s = 0.f;
#pragma unroll
            for (int j = 0; j < 4; ++j) { v[j] = (m == gw) ? mv[j] : xr[64 * j]; s += (v[j][0] * v[j][0] + v[j][1] * v[j][1]) + (v[j][2] * v[j][2] + v[j][3] * v[j][3]); }
            const float rs = rsqrtf(wave_sum(s) * (1.0f / 1024.0f) + EPS);
            unsigned long long* o8 = (unsigned long long*)(memn + (size_t)m * DM) + lane;
#pragma unroll
            for (int j = 0; j < 4; ++j) { const f32x4 y = v[j] * gm[j] * rs; o8[64 * j] = (unsigned long long)pkbf(y[0], y[1]) | ((unsigned long long)pkbf(y[2], y[3]) << 32); }
        }
    }
}

__device__ __forceinline__ void fox_cumsum(const Params& p, ldsp_t lds, int bh) {
    const int tid = threadIdx.x; const int b = bh >> 3, h = bh & 7;
    const float* logf = (const float*)(p.ws + WS_LOGF) + ((size_t)b * SEQ) * 8 + h; float* Fc = (float*)(p.ws + WS_FC) + (size_t)bh * SEQ;
    LAS double* part = (LAS double*)lds;
    double loc[8]; double run = 0.0;
#pragma unroll
    for (int i = 0; i < 8; ++i) { run += (double)logf[(size_t)(tid * 8 + i) * 8]; loc[i] = run; }
    part[tid] = run; __syncthreads();
    for (int o = 1; o < NTHR; o <<= 1) { double v = (tid >= o) ? part[tid - o] : 0.0; __syncthreads(); part[tid] += v; __syncthreads(); }
    const double base = (tid > 0) ? part[tid - 1] : 0.0;
#pragma unroll
    for (int i = 0; i < 8; ++i) Fc[tid * 8 + i] = (float)((base + loc[i]) * 1.4426950408889634);
    __syncthreads();
}

__device__ __forceinline__ void ret_kv_unit(const Params& p, ldsp_t lds, int u) {
    const int tid = threadIdx.x, lane = tid & 63, wid = __builtin_amdgcn_readfirstlane(tid >> 6), r32 = lane & 31, hi = lane >> 5;
    const int bh = u >> 5, cp = u & 31, b = bh >> 3, h = bh & 7;
    const bf16_t* P = (const bf16_t*)(p.ws + WS_P); float* kvT = (float*)(p.ws + WS_KVT);
    const float lg = log2f(1.0f - exp2f(-5.0f - (float)h));
    {
        const int ch = tid >> 8, t = tid & 255, row = t >> 2, c0 = (t & 3) * 16;
        const size_t grow = (size_t)b * SEQ + (size_t)(2 * cp + ch) * 64 + row;
        const bf16_t* kp = P + grow * PP + C_RK + h * 64 + c0; const bf16_t* vp = P + grow * PP + C_RV + h * 64 + c0;
        u32x4 k0 = *(const u32x4*)kp, k1 = *(const u32x4*)(kp + 8), v0 = *(const u32x4*)vp, v1 = *(const u32x4*)(vp + 8);
        const float dec = exp2f(lg * (float)(63 - row));
        u32x4 d0, d1;
        d0.x = pkbf(bflo(k0.x) * dec, bfhi(k0.x) * dec); d0.y = pkbf(bflo(k0.y) * dec, bfhi(k0.y) * dec); d0.z = pkbf(bflo(k0.z) * dec, bfhi(k0.z) * dec); d0.w = pkbf(bflo(k0.w) * dec, bfhi(k0.w) * dec);
        d1.x = pkbf(bflo(k1.x) * dec, bfhi(k1.x) * dec); d1.y = pkbf(bflo(k1.y) * dec, bfhi(k1.y) * dec); d1.z = pkbf(bflo(k1.z) * dec, bfhi(k1.z) * dec); d1.w = pkbf(bflo(k1.w) * dec, bfhi(k1.w) * dec);
        ldsp_t kl = lds + ch * 18432 + row * 144 + c0 * 2; ldsp_t vl = kl + 9216;
        *(LAS u32x4*)kl = d0; *(LAS u32x4*)(kl + 16) = d1; *(LAS u32x4*)vl = v0; *(LAS u32x4*)(vl + 16) = v1;
    }
    __syncthreads();
    {
        const int ch = wid >> 2, eb = (wid >> 1) & 1, db = wid & 1;
        ldsp_t kl = lds + ch * 18432, vl = kl + 9216;
        const int q = (lane & 15) >> 2, pq = lane & 3, g1 = (lane >> 4) & 1;
        f32x16 acc = {};
#pragma unroll
        for (int s = 0; s < 4; ++s) {
            const int r0 = 16 * s + 8 * hi + q;
            const bf16x8 a = cat8(tr_rd(vl + r0 * 144 + (32 * eb + 16 * g1 + 4 * pq) * 2), tr_rd(vl + (r0 + 4) * 144 + (32 * eb + 16 * g1 + 4 * pq) * 2));
            const bf16x8 bb = cat8(tr_rd(kl + r0 * 144 + (32 * db + 16 * g1 + 4 * pq) * 2), tr_rd(kl + (r0 + 4) * 144 + (32 * db + 16 * g1 + 4 * pq) * 2));
            acc = MFMA32(a, bb, acc);
        }
        float* op = kvT + ((size_t)bh * 64 + 2 * cp + ch) * 4096;
#pragma unroll
        for (int r = 0; r < 16; ++r) op[(32 * eb + crow(r, hi)) * 64 + 32 * db + r32] = acc[r];
    }
    __syncthreads();
}

__device__ __forceinline__ void knorm_pass(const Params& p, int vcu, int G) {
    const int lane = threadIdx.x & 63, wave = __builtin_amdgcn_readfirstlane((int)threadIdx.x >> 6);
    bf16_t* KV = (bf16_t*)(p.ws + WS_KVM); const float* kss = (const float*)(p.ws + WS_KSS);
    for (int it = vcu * NWAVES + wave; it < MEMROWS * 4; it += G * NWAVES) {
        const int row = it >> 2, hd = it & 3;
        const f32x4 kv4 = *(const f32x4*)(kss + (size_t)row * 16 + hd * 4);
        const float ks = rsqrtf(((kv4[0] + kv4[1]) + (kv4[2] + kv4[3])) * (1.0f / 256.0f) + EPS);
        u32x2* ptr = (u32x2*)(KV + (size_t)row * 2048 + hd * 256 + lane * 4);
        const u32x2 w = *ptr; u32x2 o; o.x = pkbf(bflo(w.x) * ks, bfhi(w.x) * ks); o.y = pkbf(bflo(w.y) * ks, bfhi(w.y) * ks); *ptr = o;
    }
}

__device__ __forceinline__ void ret_out_unit8(const Params& p, ldsp_t lds, int u) {
    const int tid = threadIdx.x, lane = tid & 63, wid = __builtin_amdgcn_readfirstlane(tid >> 6), r32 = lane & 31, hi = lane >> 5;
    const int bh = u >> 3, g8 = u & 7, b = bh >> 3, h = bh & 7, c0 = 8 * g8;
    const bf16_t* P = (const bf16_t*)(p.ws + WS_P); const float* kvT = (const float*)(p.ws + WS_KVT); bf16_t* mix = (bf16_t*)(p.ws + WS_HN);
    const float* g_ret = p.in[5] + h * 64;
    const float lg = log2f(1.0f - exp2f(-5.0f - (float)h));
    {
        const float cd = exp2f(64.0f * lg);
        const float* src = kvT + (size_t)bh * 64 * 4096 + tid * 8;
        f32x4 sa = {0.f, 0.f, 0.f, 0.f}, sb = {0.f, 0.f, 0.f, 0.f};
        int cb = 0;
        for (; cb + 16 <= c0; cb += 16) {
            f32x4 v[16][2];
#pragma unroll
            for (int j = 0; j < 16; ++j) { v[j][0] = *(const f32x4*)(src + (size_t)(cb + j) * 4096); v[j][1] = *(const f32x4*)(src + (size_t)(cb + j) * 4096 + 4); }
#pragma unroll
            for (int j = 0; j < 16; ++j) { sa = sa * cd + v[j][0]; sb = sb * cd + v[j][1]; }
        }
        if (cb < c0) {
            f32x4 v[8][2];
#pragma unroll
            for (int j = 0; j < 8; ++j) { v[j][0] = *(const f32x4*)(src + (size_t)(cb + j) * 4096); v[j][1] = *(const f32x4*)(src + (size_t)(cb + j) * 4096 + 4); }
#pragma unroll
            for (int j = 0; j < 8; ++j) { sa = sa * cd + v[j][0]; sb = sb * cd + v[j][1]; }
        }
        f32x4 own[8][2];
#pragma unroll
        for (int j = 0; j < 8; ++j) { own[j][0] = *(const f32x4*)(src + (size_t)(c0 + j) * 4096); own[j][1] = *(const f32x4*)(src + (size_t)(c0 + j) * 4096 + 4); }
        ldsp_t sl = lds + 36864 + (tid >> 3) * 144 + (tid & 7) * 16;
#pragma unroll
        for (int j = 0; j < 8; ++j) {
            u32x4 w; w.x = pkbf(sa[0], sa[1]); w.y = pkbf(sa[2], sa[3]); w.z = pkbf(sb[0], sb[1]); w.w = pkbf(sb[2], sb[3]);
            *(LAS u32x4*)(sl + j * 9216) = w;
            sa = sa * cd + own[j][0]; sb = sb * cd + own[j][1];
        }
    }
#pragma unroll 1
    for (int bt = 0; bt < 2; ++bt) {
        {
            const int ch = tid >> 7, t = tid & 127, row = t >> 1, cc0 = (t & 1) * 32;
            const bf16_t* vp = P + ((size_t)b * SEQ + (size_t)(c0 + 4 * bt + ch) * 64 + row) * PP + C_RV + h * 64 + cc0;
            ldsp_t vl = lds + ch * 9216 + row * 144 + cc0 * 2;
#pragma unroll
            for (int i = 0; i < 4; ++i) *(LAS u32x4*)(vl + 16 * i) = *(const u32x4*)(vp + 8 * i);
        }
        const int ch = wid >> 1, ih = wid & 1, c = c0 + 4 * bt + ch;
        const size_t crow0 = (size_t)b * SEQ + (size_t)c * 64;
        const int i_tok = 32 * ih + r32; const size_t row_i = crow0 + i_tok;
        bf16x8 qf[4], kf0[4], kf1[4];
#pragma unroll
        for (int s = 0; s < 4; ++s) { qf[s] = *(const bf16x8*)(P + row_i * PP + C_RQ + h * 64 + 16 * s + 8 * hi);
            kf0[s] = *(const bf16x8*)(P + (crow0 + r32) * PP + C_RK + h * 64 + 16 * s + 8 * hi);
            kf1[s] = *(const bf16x8*)(P + (crow0 + 32 + r32) * PP + C_RK + h * 64 + 16 * s + 8 * hi); }
        __syncthreads();
        f32x16 st0 = {}, st1 = {};
#pragma unroll
        for (int s = 0; s < 4; ++s) { st0 = MFMA32(kf0[s], qf[s], st0); st1 = MFMA32(kf1[s], qf[s], st1); }
#pragma unroll
        for (int r = 0; r < 16; ++r) { const int j0 = crow(r, hi), j1 = 32 + j0;
            st0[r] *= 0.125f * exp2f(lg * fabsf((float)(i_tok - j0))); st1[r] *= 0.125f * exp2f(lg * fabsf((float)(i_tok - j1))); }
        bf16x8 pf[4]; pf[0] = pack8(st0, 0); pf[1] = pack8(st0, 1); pf[2] = pack8(st1, 0); pf[3] = pack8(st1, 1);
        ldsp_t vl = lds + ch * 9216; ldsp_t sl = lds + 36864 + (4 * bt + ch) * 9216;
        const int q = (lane & 15) >> 2, pq = lane & 3, g1 = (lane >> 4) & 1;
        f32x16 o0 = {}, o1 = {}, t0 = {}, t1 = {};
#pragma unroll
        for (int s = 0; s < 4; ++s) {
            const int r0 = 16 * s + 4 * hi + q;
            const bf16x8 a0 = cat8(tr_rd(vl + r0 * 144 + (16 * g1 + 4 * pq) * 2), tr_rd(vl + (r0 + 8) * 144 + (16 * g1 + 4 * pq) * 2));
            const bf16x8 a1 = cat8(tr_rd(vl + r0 * 144 + (32 + 16 * g1 + 4 * pq) * 2), tr_rd(vl + (r0 + 8) * 144 + (32 + 16 * g1 + 4 * pq) * 2));
            o0 = MFMA32(a0, pf[s], o0); o1 = MFMA32(a1, pf[s], o1);
            const bf16x8 s0 = *(const LAS bf16x8*)(sl + r32 * 144 + (16 * s + 8 * hi) * 2);
            const bf16x8 s1 = *(const LAS bf16x8*)(sl + (32 + r32) * 144 + (16 * s + 8 * hi) * 2);
            t0 = MFMA32(s0, qf[s], t0); t1 = MFMA32(s1, qf[s], t1);
        }
        const float qd = 0.125f * exp2f(lg * (float)(i_tok + 1));
        float sum = 0.f;
#pragma unroll
        for (int r = 0; r < 16; ++r) { o0[r] += qd * t0[r]; o1[r] += qd * t1[r]; sum += o0[r] + o1[r]; }
        sum += __shfl_xor(sum, 32); const float mu = sum * (1.0f / 64.0f);
        float var = 0.f;
#pragma unroll
        for (int r = 0; r < 16; ++r) { o0[r] -= mu; o1[r] -= mu; var += o0[r] * o0[r] + o1[r] * o1[r]; }
        var += __shfl_xor(var, 32); const float rstd = rsqrtf(var * (1.0f / 64.0f) + EPS);
        const bf16_t* gp = P + row_i * PP + C_RG + h * 64; bf16_t* mp = mix + row_i * DM + h * 64;
#pragma unroll
        for (int eb = 0; eb < 2; ++eb)
#pragma unroll
            for (int g = 0; g < 4; ++g) {
                const int e0 = 32 * eb + 8 * g + 4 * hi;
                const u32x2 gw = *(const u32x2*)(gp + e0); const f32x4 gr = *(const f32x4*)(g_ret + e0);
                const float gt[4] = {bflo(gw.x), bfhi(gw.x), bflo(gw.y), bfhi(gw.y)}; float y[4];
#pragma unroll
                for (int e = 0; e < 4; ++e) { const float v = (eb ? o1[4 * g + e] : o0[4 * g + e]) * rstd * gr[e]; const float z = gt[e];
                    y[e] = v * z * __builtin_amdgcn_rcpf(1.0f + __builtin_amdgcn_exp2f(-z * LOG2E)); }
                u32x2 w; w.x = pkbf(y[0], y[1]); w.y = pkbf(y[2], y[3]); st8(mp + e0, w);
            }
        __syncthreads();
    }
}

__device__ __forceinline__ void fox_unit(const Params& p, ldsp_t lds, int bh, int qb, float thr) {
    const int tid = threadIdx.x, lane = tid & 63, wid = __builtin_amdgcn_readfirstlane(tid >> 6), r32 = lane & 31, hi = lane >> 5;
    const int b = bh >> 3, h = bh & 7; const size_t rowbase = (size_t)b * SEQ; const int t0 = qb * 256;
    const bf16_t* P = (const bf16_t*)(p.ws + WS_P); bf16_t* mix = (bf16_t*)(p.ws + WS_HN);
    const bf16_t* Kg = P + rowbase * PP + C_FK + h * 64; const bf16_t* Vg = P + rowbase * PP + C_FV + h * 64;
    const float* Fg = (const float*)(p.ws + WS_FC) + (size_t)bh * SEQ;
    const int NT = 2 * qb + 2;
    const size_t qrow = rowbase + t0 + wid * 32 + r32;
    const int srow = tid >> 3, sch = tid & 7;
    bf16x8 qr[4];
#pragma unroll
    for (int s = 0; s < 4; ++s) qr[s] = *(const bf16x8*)(P + qrow * PP + C_FQ + h * 64 + 16 * s + 8 * hi);
    u32x4 kreg0, kreg1, vreg0, vreg1; float freg = 0.f;
    { const size_t r = (size_t)(NT - 1) * 128 + srow;
      kreg0 = *(const u32x4*)(Kg + r * PP + sch * 8); kreg1 = *(const u32x4*)(Kg + (r + 64) * PP + sch * 8);
      vreg0 = *(const u32x4*)(Vg + r * PP + sch * 8); vreg1 = *(const u32x4*)(Vg + (r + 64) * PP + sch * 8); }
    const float fref = Fg[t0];
    const float fl = Fg[128 * (lane < NT ? lane : 0) + 127];
    const float ft = (tid < 128) ? Fg[(NT - 1) * 128 + tid] : 0.f;
    if (tid < 128) freg = fref - ft;
    int tk0;
    { const bool ok = (lane < NT) && ((fref - fl) >= -thr);
      const unsigned long long mk = __ballot(ok); tk0 = mk ? (int)__builtin_ctzll(mk) : (NT - 2); if (tk0 > NT - 2) tk0 = NT - 2;
      tk0 = __builtin_amdgcn_readfirstlane(tk0); }
    *(LAS u32x4*)(lds + srow * 144 + sch * 16) = kreg0; *(LAS u32x4*)(lds + (srow + 64) * 144 + sch * 16) = kreg1;
    *(LAS u32x4*)(lds + 36864 + srow * 144 + sch * 16) = vreg0; *(LAS u32x4*)(lds + 36864 + (srow + 64) * 144 + sch * 16) = vreg1;
    if (tid < 128) *(LAS float*)(lds + 73728 + tid * 4) = freg;
    __syncthreads();
    f32x16 o0 = {}, o1 = {}; float mrun = -INFINITY, lrun = 0.f;
    const int qrel = wid * 32 + r32;
    const int q = (lane & 15) >> 2, pq = lane & 3, g1 = (lane >> 4) & 1;
    int buf = 0;
    for (int tk = NT - 1; tk >= tk0; --tk) {
        const bool more = (tk > tk0);
        if (more) { const size_t r = (size_t)(tk - 1) * 128 + srow;
            kreg0 = *(const u32x4*)(Kg + r * PP + sch * 8); kreg1 = *(const u32x4*)(Kg + (r + 64) * PP + sch * 8);
            vreg0 = *(const u32x4*)(Vg + r * PP + sch * 8); vreg1 = *(const u32x4*)(Vg + (r + 64) * PP + sch * 8);
            if (tid < 128) freg = fref - Fg[(tk - 1) * 128 + tid]; }
        const int jb = tk - (NT - 2);
        if (!(jb >= 0 && 128 * jb > wid * 32 + 31)) {
            ldsp_t kl = lds + buf * 18432, vl = lds + 36864 + buf * 18432; const LAS float* nb = (const LAS float*)(lds + 73728 + buf * 512);
            f32x16 pb[4];
#pragma unroll
            for (int blk = 0; blk < 4; ++blk)
#pragma unroll
                for (int g = 0; g < 4; ++g) { const f32x4 n0 = *(const LAS f32x4*)(nb + 32 * blk + 8 * g + 4 * hi);
#pragma unroll
                    for (int e = 0; e < 4; ++e) pb[blk][4 * g + e] = n0[e]; }
#pragma unroll
            for (int s = 0; s < 4; ++s)
#pragma unroll
                for (int blk = 0; blk < 4; ++blk) {
                    const bf16x8 kf = *(const LAS bf16x8*)(kl + (32 * blk + r32) * 144 + (16 * s + 8 * hi) * 2);
                    pb[blk] = MFMA32(kf, qr[s], pb[blk]);
                }
            if (jb >= 0) {
#pragma unroll
                for (int blk = 0; blk < 4; ++blk)
#pragma unroll
                    for (int r = 0; r < 16; ++r) { const int kv = 128 * jb + 32 * blk + crow(r, hi); if (kv > qrel) pb[blk][r] = -INFINITY; }
            }
            float bm[4];
#pragma unroll
            for (int blk = 0; blk < 4; ++blk) { float m4 = pb[blk][0];
#pragma unroll
                for (int r = 1; r < 16; r += 2) m4 = fmaxf(m4, fmaxf(pb[blk][r], pb[blk][r < 15 ? r + 1 : r])); bm[blk] = m4; }
            float mx = fmaxf(fmaxf(bm[0], bm[1]), fmaxf(bm[2], bm[3]));
            mx = fmaxf(mx, __shfl_xor(mx, 32));
            const float mnew = fmaxf(mrun, mx);
            if (__any(mnew != mrun)) {
                const float sc = __builtin_amdgcn_exp2f(mrun - mnew); lrun *= sc;
#pragma unroll
                for (int r = 0; r < 16; ++r) { o0[r] *= sc; o1[r] *= sc; }
            }
            mrun = mnew;
            float rsum = 0.f;
#pragma unroll
            for (int blk = 0; blk < 4; ++blk) {
                if (__all(bm[blk] < mnew - 40.0f)) continue;
#pragma unroll
                for (int r = 0; r < 16; ++r) { pb[blk][r] = __builtin_amdgcn_exp2f(pb[blk][r] - mnew); rsum += pb[blk][r]; }
#pragma unroll
                for (int hf = 0; hf < 2; ++hf) {
                    const int s = 2 * blk + hf;
                    const bf16x8 pf = pack8(pb[blk], hf);
                    const int r0 = 16 * s + 4 * hi + q;
                    const bf16x8 a0 = cat8(tr_rd(vl + r0 * 144 + (16 * g1 + 4 * pq) * 2), tr_rd(vl + (r0 + 8) * 144 + (16 * g1 + 4 * pq) * 2));
                    const bf16x8 a1 = cat8(tr_rd(vl + r0 * 144 + (32 + 16 * g1 + 4 * pq) * 2), tr_rd(vl + (r0 + 8) * 144 + (32 + 16 * g1 + 4 * pq) * 2));
                    o0 = MFMA32(a0, pf, o0); o1 = MFMA32(a1, pf, o1);
                }
            }
            lrun += rsum;
        }
        if (more) { const int nbuf = buf ^ 1;
            *(LAS u32x4*)(lds + nbuf * 18432 + srow * 144 + sch * 16) = kreg0; *(LAS u32x4*)(lds + nbuf * 18432 + (srow + 64) * 144 + sch * 16) = kreg1;
            *(LAS u32x4*)(lds + 36864 + nbuf * 18432 + srow * 144 + sch * 16) = vreg0; *(LAS u32x4*)(lds + 36864 + nbuf * 18432 + (srow + 64) * 144 + sch * 16) = vreg1;
            if (tid < 128) *(LAS float*)(lds + 73728 + nbuf * 512 + tid * 4) = freg; }
        __syncthreads();
        buf ^= 1;
    }
    lrun += __shfl_xor(lrun, 32);
    const float inv = 1.0f / lrun;
    bf16_t* mp = mix + qrow * DM + 512 + h * 64;
#pragma unroll
    for (int g = 0; g < 4; ++g) {
        u32x2 w0, w1; w0.x = pkbf(o0[4 * g] * inv, o0[4 * g + 1] * inv); w0.y = pkbf(o0[4 * g + 2] * inv, o0[4 * g + 3] * inv);
        w1.x = pkbf(o1[4 * g] * inv, o1[4 * g + 1] * inv); w1.y = pkbf(o1[4 * g + 2] * inv, o1[4 * g + 3] * inv);
        st8(mp + 8 * g + 4 * hi, w0); st8(mp + 32 + 8 * g + 4 * hi, w1);
    }
}
__device__ __forceinline__ void fox_phase(const Params& p, ldsp_t lds) {
    const int tid = threadIdx.x, lane = tid & 63;
    float amax = fabsf(p.in[6][lane]), bmax = fabsf(p.in[7][lane]);
#pragma unroll
    for (int o = 1; o < 64; o <<= 1) { amax = fmaxf(amax, __shfl_xor(amax, o)); bmax = fmaxf(bmax, __shfl_xor(bmax, o)); }
    const float thr = 2.0f * (8.0f * amax * bmax * LOG2E) + 40.0f;
    volatile LAS int* qw = (volatile LAS int*)(lds + 147200 + 128);
    unsigned* ctr = (unsigned*)p.ws + 3584;
    for (;;) {
        if (tid == 0) *qw = (int)atomicAdd(ctr, 1u);
        __syncthreads();
        const int idx = *qw;
        __syncthreads();
        if (idx >= 512 + 1024) break;
        if (idx < 512) fox_unit(p, lds, idx & 31, 15 - (idx >> 5), thr);
        else ret_kv_unit(p, lds, idx - 512);
    }
}

__device__ __forceinline__ void xattn_unit(const Params& p, ldsp_t lds, int u) {
    const int tid = threadIdx.x, lane = tid & 63, wid = __builtin_amdgcn_readfirstlane(tid >> 6), r32 = lane & 31, hi = lane >> 5;
    const int b = u >> 6, qblk = (u & 63) >> 2, hd = u & 3;
    const bf16_t* qx = (const bf16_t*)(p.ws + WS_QX); const bf16_t* KV = (const bf16_t*)(p.ws + WS_KVM); bf16_t* ob = (bf16_t*)(p.ws + WS_O);
    const float* ss1 = (const float*)(p.ws + WS_SS1); const float* qss = (const float*)(p.ws + WS_QSS); const float* kss = (const float*)(p.ws + WS_KSS);
    const size_t R = (size_t)b * SEQ + qblk * 256 + wid * 32 + r32;
    const int srow = tid >> 3, spart = tid & 7;
    const bf16_t* kvbase = KV + ((size_t)b * NMEM + srow) * 2048 + hd * 256 + spart * 32;
    {
        u32x4 kr[4][4];
#pragma unroll
        for (int ps = 0; ps < 4; ++ps)
#pragma unroll
            for (int i = 0; i < 4; ++i) kr[ps][i] = *(const u32x4*)(kvbase + (size_t)ps * 64 * 2048 + 8 * i);
#pragma unroll
        for (int ps = 0; ps < 4; ++ps)
#pragma unroll
            for (int i = 0; i < 4; ++i) *(LAS u32x4*)(lds + (ps * 64 + srow) * 560 + spart * 64 + 16 * i) = kr[ps][i];
    }
    float qscale;
    { const f32x4* sp = (const f32x4*)(ss1 + R * 16); const f32x4 a = sp[0], bq = sp[1], c = sp[2], d = sp[3];
      const float tot = ((a[0] + a[1]) + (a[2] + a[3])) + ((bq[0] + bq[1]) + (bq[2] + bq[3])) + ((c[0] + c[1]) + (c[2] + c[3])) + ((d[0] + d[1]) + (d[2] + d[3]));
      const float r1 = rsqrtf(tot * (1.0f / 1024.0f) + EPS);
      const f32x4 qv = *(const f32x4*)(qss + R * 16 + hd * 4); const float qs = (qv[0] + qv[1]) + (qv[2] + qv[3]);
      qscale = r1 * rsqrtf(r1 * r1 * qs * (1.0f / 256.0f) + EPS) * (0.0625f * LOG2E); }
    const bf16_t* qp = qx + R * DM + hd * 256 + 8 * hi;
    __syncthreads();
    f32x16 S[8];
#pragma unroll
    for (int i = 0; i < 8; ++i) S[i] = (f32x16){};
#pragma unroll 8
    for (int s = 0; s < 16; ++s) {
        const bf16x8 qf = *(const bf16x8*)(qp + 16 * s);
#pragma unroll
        for (int blk = 0; blk < 8; ++blk) {
            const bf16x8 kf = *(const LAS bf16x8*)(lds + (32 * blk + r32) * 560 + (16 * s + 8 * hi) * 2);
            S[blk] = MFMA32(kf, qf, S[blk]);
        }
    }
    float mx = -INFINITY;
#pragma unroll
    for (int blk = 0; blk < 8; ++blk)
#pragma unroll
        for (int r = 0; r < 16; ++r) mx = fmaxf(mx, S[blk][r]);
    mx *= qscale;
    mx = fmaxf(mx, __shfl_xor(mx, 32));
    float lsum = 0.f;
    bf16x8 pf[16];
#pragma unroll
    for (int blk = 0; blk < 8; ++blk) {
        f32x16 e;
#pragma unroll
        for (int r = 0; r < 16; ++r) { e[r] = __builtin_amdgcn_exp2f(S[blk][r] * qscale - mx); lsum += e[r]; }
        pf[2 * blk] = pack8(e, 0); pf[2 * blk + 1] = pack8(e, 1);
        asm volatile("" : "+v"(pf[2 * blk]), "+v"(pf[2 * blk + 1]));
    }
    lsum += __shfl_xor(lsum, 32);
    const float inv = 1.0f / lsum;
    __syncthreads();
    const bf16_t* vbase = kvbase + 1024;
#pragma unroll
    for (int hp = 0; hp < 2; ++hp) {
        u32x4 vr[2][4];
#pragma unroll
        for (int ps = 0; ps < 2; ++ps)
#pragma unroll
            for (int i = 0; i < 4; ++i) vr[ps][i] = *(const u32x4*)(vbase + (size_t)(2 * hp + ps) * 64 * 2048 + 8 * i);
#pragma unroll
        for (int ps = 0; ps < 2; ++ps)
#pragma unroll
            for (int i = 0; i < 4; ++i) *(LAS u32x4*)(lds + ((2 * hp + ps) * 64 + srow) * 560 + spart * 64 + 16 * i) = vr[ps][i];
        asm volatile("" ::: "memory");
    }
    __syncthreads();
    const int q = (lane & 15) >> 2, pq = lane & 3, g1 = (lane >> 4) & 1;
    bf16_t* op = ob + R * DM + hd * 256;
#pragma unroll
    for (int blk = 0; blk < 8; ++blk) {
        f32x16 o = {};
#pragma unroll
        for (int s = 0; s < 16; ++s) {
            const int r0 = 16 * s + 4 * hi + q;
            const bf16x8 a = cat8(tr_rd(lds + r0 * 560 + (32 * blk + 16 * g1 + 4 * pq) * 2), tr_rd(lds + (r0 + 8) * 560 + (32 * blk + 16 * g1 + 4 * pq) * 2));
            o = MFMA32(a, pf[s], o);
        }
#pragma unroll
        for (int g = 0; g < 4; ++g) {
            u32x2 w; w.x = pkbf(o[4 * g] * inv, o[4 * g + 1] * inv); w.y = pkbf(o[4 * g + 2] * inv, o[4 * g + 3] * inv);
            st8(op + 32 * blk + 8 * g + 4 * hi, w);
        }
    }
    __syncthreads();
}

__global__ void __launch_bounds__(NTHR, 2) hymba_fwd(Params p, int ph_lo, int ph_hi, int coop) {
    extern __shared__ __attribute__((aligned(16))) unsigned char lds_raw[];
    ldsp_t lds = (ldsp_t)lds_raw;
    const int G = gridDim.x, bx = blockIdx.x;
    const int vcu = (G % 8 == 0) ? (bx % 8) * (G / 8) + bx / 8 : bx;
    unsigned char* ws = p.ws;
    bf16_t* HN = (bf16_t*)(ws + WS_HN); bf16_t* PB = (bf16_t*)(ws + WS_P);
    if (threadIdx.x < 64) ((LAS unsigned*)(lds + 147200))[threadIdx.x] = 0u;
    __syncthreads();
    XcdBarrier bar = xcd_barrier_post((unsigned*)ws, (volatile LAS unsigned*)(lds + 147200 + 32));
    if (coop == 2) cg::this_grid().sync();
#define IN(k) (ph_lo <= (k) && (k) < ph_hi)
#define SEAM(k) do { if (coop && IN(k) && IN((k) + 1)) xcd_barrier(bar); } while (0)
    if (IN(0)) { p0_prologue(p, lds, vcu, G); __syncthreads(); }
    SEAM(0);
    if (IN(1)) {
        { pg8::Gemm g{HN, (const bf16_t*)(ws + WS_WIN), MROWS, 3584, 1024}; pg8::StaticOrder S; S.init(MROWS, 3584, G, bx);
          pg8::EpiProj E{PB, (const float*)(ws + WS_COS), (const float*)(ws + WS_SIN), p.in[6], p.in[7]};
          pg8::gemm_phase<pg8::EpiProj, pg8::StaticOrder, true, true>(lds, g, S, E); }
        { pg8::Gemm g{(const bf16_t*)(ws + WS_MEMN), (const bf16_t*)(ws + WS_WXKV), MEMROWS, 2048, 1024}; pg8::StaticOrder S; S.init(MEMROWS, 2048, G, (bx + G / 2) % G);
          pg8::EpiKV E{(bf16_t*)(ws + WS_KVM), (float*)(ws + WS_KSS), p.in[13], p.in[14]};
          pg8::gemm_phase<pg8::EpiKV, pg8::StaticOrder, true, true>(lds, g, S, E); }
        __syncthreads();
        if (LATE_W && bx >= 160) { const int wave = __builtin_amdgcn_readfirstlane((int)threadIdx.x >> 6);
            weight_items(p, (LAS float*)(lds + wave * 8448), (int)threadIdx.x & 63, (bx - 160) * NWAVES + wave, 96 * NWAVES, W_EARLY, W_ALL); __syncthreads(); }
        if (G >= 192) { if (bx >= 160 && bx < 192) fox_cumsum(p, lds, bx - 160); }
        else { for (int bh = bx; bh < 32; bh += G) fox_cumsum(p, lds, bh); }
    }
    SEAM(1);
    if (IN(2)) fox_phase(p, lds);
    SEAM(2);
    if (IN(4)) { for (int u = vcu; u < 256; u += G) ret_out_unit8(p, lds, u); knorm_pass(p, vcu, G); }
    SEAM(4);
    if (IN(5)) { pg8::Gemm g{HN, (const bf16_t*)(ws + WS_WOUT), MROWS, 1024, 1024}; pg8::StaticOrder S; S.init(MROWS, 1024, G, bx);
        pg8::EpiRes<false> E{p.in[0], nullptr, (bf16_t*)(ws + WS_H1B), (float*)(ws + WS_SS1)};
        pg8::gemm_phase<pg8::EpiRes<false>, pg8::StaticOrder, true, true>(lds, g, S, E); }
    SEAM(5);
    if (IN(6)) { pg8::Gemm g{(const bf16_t*)(ws + WS_H1B), (const bf16_t*)(ws + WS_WXQ), MROWS, 1024, 1024}; pg8::StaticOrder S; S.init(MROWS, 1024, G, bx);
        pg8::EpiXq E{(bf16_t*)(ws + WS_QX), (float*)(ws + WS_QSS)};
        pg8::gemm_phase<pg8::EpiXq, pg8::StaticOrder, true, true>(lds, g, S, E);
        asm volatile("s_waitcnt vmcnt(0)" ::: "memory");
        __syncthreads();
        if (threadIdx.x == 0) { __builtin_amdgcn_fence(__ATOMIC_ACQUIRE, "agent"); asm volatile("s_waitcnt vmcnt(0)" ::: "memory"); }
        __syncthreads();
        pg8::Unit un;
        for (int i = 0; S.next(i, un); ++i) xattn_unit(p, lds, ((un.pm >> 4) << 6) | ((un.pm & 15) << 2) | un.pn);
    }
    SEAM(6);
    if (IN(8)) { pg8::Gemm g{(const bf16_t*)(ws + WS_O), (const bf16_t*)(ws + WS_WXO), MROWS, 1024, 1024}; pg8::StaticOrder S; S.init(MROWS, 1024, G, bx);
        pg8::EpiRes<true> E{(const void*)(ws + WS_H1B), nullptr, (bf16_t*)(ws + WS_H1B), (float*)(ws + WS_SS2)};
        pg8::gemm_phase<pg8::EpiRes<true>, pg8::StaticOrder, true, true>(lds, g, S, E); }
    SEAM(8);
    if (IN(9)) { pg8::Gemm g{(const bf16_t*)(ws + WS_H1B), (const bf16_t*)(ws + WS_WGU), MROWS, 5632, 1024}; pg8::StaticOrder S; S.init(MROWS, 5632, G, bx);
        const LAS float* rl = nullptr;
        { pg8::Unit u0, ui; bool same = S.next(0, u0);
          for (int i = 1; same && S.next(i, ui); ++i) same = (ui.pm == u0.pm);
          if (same) { LAS float* rt = (LAS float*)(lds + 131072);
              if (threadIdx.x < 256) { const f32x4* sp = (const f32x4*)((const float*)(ws + WS_SS2) + ((size_t)u0.pm * 256 + threadIdx.x) * 16); const f32x4 s0 = sp[0], s1 = sp[1], s2 = sp[2], s3 = sp[3];
                  const float tot = ((s0[0] + s0[1]) + (s0[2] + s0[3])) + ((s1[0] + s1[1]) + (s1[2] + s1[3])) + ((s2[0] + s2[1]) + (s2[2] + s2[3])) + ((s3[0] + s3[1]) + (s3[2] + s3[3]));
                  rt[threadIdx.x] = rsqrtf(tot * (1.0f / 1024.0f) + EPS); }
              __syncthreads(); rl = rt; } }
        pg8::EpiGU E{(bf16_t*)(ws + WS_ACT), (const float*)(ws + WS_SS2), rl};
        pg8::gemm_phase<pg8::EpiGU, pg8::StaticOrder, true, true>(lds, g, S, E);
        if (LATE_W && bx >= 128) { __syncthreads(); const int wave = __builtin_amdgcn_readfirstlane((int)threadIdx.x >> 6);
            weight_items(p, (LAS float*)(lds + wave * 8448), (int)threadIdx.x & 63, (bx - 128) * NWAVES + wave, 128 * NWAVES, W_P1, W_EARLY); __syncthreads(); } }
    SEAM(9);
    if (IN(10)) { pg8::Gemm g{(const bf16_t*)(ws + WS_ACT), (const bf16_t*)(ws + WS_WD), MROWS, 1024, DFF}; pg8::StaticOrder S; S.init(MROWS, 1024, G, bx);
        pg8::EpiRes<true> E{(const void*)(ws + WS_H1B), p.out, nullptr, nullptr};
        pg8::gemm_phase<pg8::EpiRes<true>, pg8::StaticOrder, true, true>(lds, g, S, E); }
#undef IN
#undef SEAM
}

#ifndef N_LAUNCH_MODE
#define N_LAUNCH_MODE 1
#endif
extern "C" void kernel_launch(void* const* d_in, const int* in_sizes, int n_in, void* d_out, int out_size, void* d_ws, size_t ws_size, hipStream_t stream) {
    static int grid = 0;
    if (grid == 0) {
        int dev = 0, cus = 0, per_cu = 0;
        (void)hipGetDevice(&dev); (void)hipDeviceGetAttribute(&cus, hipDeviceAttributeMultiprocessorCount, dev);
        if (hipFuncSetAttribute((const void*)hymba_fwd, hipFuncAttributeMaxDynamicSharedMemorySize, LDS_BYTES) != hipSuccess) fprintf(stderr, "kernel_launch: hipFuncSetAttribute(%d B dynamic LDS) failed\n", LDS_BYTES);
        if (hipOccupancyMaxActiveBlocksPerMultiprocessor(&per_cu, (const void*)hymba_fwd, NTHR, LDS_BYTES) != hipSuccess || per_cu < 1) { fprintf(stderr, "kernel_launch: occupancy query reports %d workgroups per CU\n", per_cu); per_cu = 1; }
        (void)hipGetLastError();
        grid = cus * (per_cu > 1 ? 1 : per_cu);
        if (n_in != 20 || ws_size < WS_END || in_sizes[0] != MROWS * DM || out_size != MROWS * DM) fprintf(stderr, "kernel_launch: unexpected problem (n_in %d, ws %zu)\n", n_in, ws_size);
    }
    Params p{};
    for (int i = 0; i < 20; ++i) p.in[i] = (const float*)d_in[i];
    p.out = (float*)d_out; p.ws = (unsigned char*)d_ws;
    (void)hipMemsetAsync(d_ws, 0, 16384, stream);
    if (N_LAUNCH_MODE == 1) {
        int lo = 0, hi = 11, coop = 1;
        void* args[] = {&p, &lo, &hi, &coop};
        hipError_t e = hipLaunchCooperativeKernel((const void*)hymba_fwd, dim3(grid), dim3(NTHR), args, LDS_BYTES, stream);
        if (e != hipSuccess) fprintf(stderr, "kernel_launch: cooperative launch failed: %s (grid %d)\n", hipGetErrorString(e), grid);
    } else {
        for (int ph = 0; ph < 11; ++ph) hipLaunchKernelGGL(hymba_fwd, dim3(grid), dim3(NTHR), LDS_BYTES, stream, p, ph, ph + 1, 0);
    }
}
```
